# Optimizing an MI355X kernel written in HIP

```python
import jax, jax.numpy as jnp
from jax import lax
import numpy as np

D_MODEL = 2048
BATCH = 4
SEQ = 2048
DEPTH = 2

N_META = 16
GRID_W = 64
GLA_HEADS = 4
GLA_DK = 128
GLA_DV = 256
GLA_RANK = 16
GLA_TAU = 16.0
GLA_CHUNK = 64
NA_HEADS = 16
NA_DH = 64
NA_WIN_H = 8
NA_WIN_W = 16
NA_QB = 16
NA_KB = 32
D_FF = 4 * D_MODEL
DEEPNORM_ALPHA = (2 * DEPTH) ** 0.25
DEEPNORM_BETA = (8 * DEPTH) ** -0.25
LN_EPS = 1e-5

MIX_WIDTH = GLA_HEADS * GLA_DV + NA_HEADS * NA_DH
PROJ_SIZES = (GLA_HEADS * GLA_DK, GLA_HEADS * GLA_DK, GLA_HEADS * GLA_DV, GLA_HEADS * GLA_DV,
              2 * GLA_RANK, NA_HEADS * NA_DH, NA_HEADS * NA_DH, NA_HEADS * NA_DH)

kernel_name = "hybrid_gla_natten_deepnorm_encoder"


def _layer_norm(x, w, b):
    xf = x.astype(jnp.float32)
    mu = jnp.mean(xf, axis=-1, keepdims=True)
    var = jnp.mean(jnp.square(xf - mu), axis=-1, keepdims=True)
    y = (xf - mu) * lax.rsqrt(var + LN_EPS) * w.astype(jnp.float32) + b.astype(jnp.float32)
    return y.astype(x.dtype)


def _to_chunks(t, n_heads):
    B, Lp, W = t.shape
    return t.reshape(B, Lp // GLA_CHUNK, GLA_CHUNK, n_heads, W // n_heads).transpose(1, 0, 3, 2, 4)


def _from_chunks(t):
    N, B, H, C, d = t.shape
    return t.transpose(1, 0, 3, 2, 4).reshape(B, N * C, H * d)


def _gla_scan(q, k, v, g):
    qc, kc, vc, gc = (_to_chunks(t, GLA_HEADS) for t in (q, k, v, g))
    B = q.shape[0]
    C = GLA_CHUNK
    incl = jnp.tril(jnp.ones((C, C), dtype=bool))[:, :, None]

    def step(S, inp):
        qi, ki, vi, gi = inp
        bcum = jnp.cumsum(gi, axis=-2)
        b_last = bcum[..., -1:, :]
        inter = jnp.einsum('bhtd,bhde->bhte', qi * jnp.exp(bcum), S)
        diff = bcum[..., :, None, :] - bcum[..., None, :, :]
        decay = jnp.exp(jnp.where(incl, diff, -jnp.inf))
        scores = jnp.einsum('bhtd,bhsd,bhtsd->bhts', qi, ki, decay)
        intra = jnp.einsum('bhts,bhse->bhte', scores, vi)
        S = (jnp.exp(b_last[..., 0, :])[..., None] * S
             + jnp.einsum('bhsd,bhse->bhde', ki * jnp.exp(b_last - bcum), vi))
        return S, inter + intra

    S0 = jnp.zeros((B, GLA_HEADS, GLA_DK, GLA_DV), jnp.float32)
    _, out = lax.scan(step, S0, (qc, kc, vc, gc))
    return _from_chunks(out)


def _gla_mixer(q, k, v, r, gate_lr, w_up, b_up, norm_w):
    B, L, _ = q.shape
    f32 = jnp.float32
    pad = GLA_CHUNK - N_META
    lr = gate_lr.astype(f32).reshape(B, L, 2, GLA_RANK)
    g = jax.nn.log_sigmoid(jnp.einsum('blzr,zrk->blzk', lr, w_up.astype(f32))
                           + b_up.astype(f32)) / GLA_TAU
    padf = lambda t: jnp.pad(t, ((0, 0), (pad, 0), (0, 0)))
    qp = padf(q.astype(f32) * GLA_DK ** -0.5)
    kp = padf(k.astype(f32))
    vp = padf(v.astype(f32))
    g_fwd = padf(g[:, :, 0])
    g_bwd = padf(g[:, :, 1])
    flip = lambda t: jnp.flip(t, axis=1)
    o_fwd = _gla_scan(qp, kp, vp, g_fwd)
    o_bwd = flip(_gla_scan(flip(qp), flip(kp), flip(vp), flip(g_bwd)))
    o = (o_fwd + o_bwd)[:, pad:].reshape(B, L, GLA_HEADS, GLA_DV)
    o = o * lax.rsqrt(jnp.mean(jnp.square(o), axis=-1, keepdims=True) + LN_EPS) * norm_w.astype(f32)
    o = o.reshape(B, L, GLA_HEADS * GLA_DV) * jax.nn.silu(r.astype(f32))
    return o.astype(q.dtype)


def _na_mixer(q, k, v, rel_bias):
    B, L, _ = q.shape
    T = L - N_META
    rows = T // GRID_W
    kh = min(NA_WIN_H, rows)
    ncb = GRID_W // NA_QB
    f32 = jnp.float32
    split = lambda t: t.astype(f32).reshape(B, L, NA_HEADS, NA_DH).transpose(0, 2, 1, 3)
    q, k, v = split(q) * NA_DH ** -0.5, split(k), split(v)
    qm, km, vm = q[:, :, :N_META], k[:, :, :N_META], v[:, :, :N_META]
    meta_out = jnp.einsum('bhqk,bhkd->bhqd',
                          jax.nn.softmax(jnp.einsum('bhqd,bhkd->bhqk', qm, km), axis=-1), vm)
    qg = q[:, :, N_META:].reshape(B, NA_HEADS, rows, GRID_W, NA_DH)
    kg = k[:, :, N_META:].reshape(B, NA_HEADS, rows, GRID_W, NA_DH)
    vg = v[:, :, N_META:].reshape(B, NA_HEADS, rows, GRID_W, NA_DH)

    col = np.arange(GRID_W)
    cs = np.clip(col - NA_WIN_W // 2, 0, GRID_W - NA_WIN_W).reshape(ncb, NA_QB)
    q_col = col.reshape(ncb, NA_QB)
    cb = np.clip(np.arange(ncb) * NA_QB - NA_WIN_W // 2, 0, GRID_W - NA_KB)
    key_col = cb[:, None] + np.arange(NA_KB)
    col_mask = ((key_col[:, None, :] >= cs[:, :, None])
                & (key_col[:, None, :] < cs[:, :, None] + NA_WIN_W))
    dc_idx = np.clip(key_col[:, None, :] - q_col[:, :, None],
                     -(NA_WIN_W - 1), NA_WIN_W - 1) + NA_WIN_W - 1
    bias_tab = rel_bias.astype(f32)
    n_loc = kh * NA_KB

    def row_attn(args):
        r, q_row = args
        rs = jnp.clip(r - kh // 2, 0, rows - kh)
        k_blk = lax.dynamic_slice_in_dim(kg, rs, kh, axis=2)[:, :, :, key_col, :]
        v_blk = lax.dynamic_slice_in_dim(vg, rs, kh, axis=2)[:, :, :, key_col, :]
        qb = q_row.reshape(B, NA_HEADS, ncb, NA_QB, NA_DH)
        s_loc = jnp.einsum('bhnqd,bhrnkd->bhnqrk', qb, k_blk)
        dr_idx = rs + jnp.arange(kh) - r + NA_WIN_H - 1
        bias = bias_tab[:, dr_idx[:, None, None, None], dc_idx[None]]
        bias = jnp.transpose(bias, (0, 2, 3, 1, 4))
        s_loc = jnp.where(col_mask[:, :, None, :], s_loc + bias, -jnp.inf)
        s_meta = jnp.einsum('bhnqd,bhmd->bhnqm', qb, km)
        s = jnp.concatenate([s_loc.reshape(B, NA_HEADS, ncb, NA_QB, n_loc), s_meta], axis=-1)
        p = jax.nn.softmax(s, axis=-1)
        p_loc = p[..., :n_loc].reshape(B, NA_HEADS, ncb, NA_QB, kh, NA_KB)
        out = (jnp.einsum('bhnqrk,bhrnkd->bhnqd', p_loc, v_blk)
               + jnp.einsum('bhnqm,bhmd->bhnqd', p[..., n_loc:], vm))
        return out.reshape(B, NA_HEADS, GRID_W, NA_DH)

    grid_out = lax.map(row_attn, (jnp.arange(rows), jnp.moveaxis(qg, 2, 0)))
    grid_out = jnp.moveaxis(grid_out, 0, 2).reshape(B, NA_HEADS, T, NA_DH)
    out = jnp.concatenate([meta_out, grid_out], axis=2)
    return out.transpose(0, 2, 1, 3).reshape(B, L, NA_HEADS * NA_DH)


def _layer(h, w_in, gla_w_up, gla_b_up, gla_norm_w, na_rel_bias, w_out,
           ln1_w, ln1_b, w_ff1, w_ff2, ln2_w, ln2_b):
    proj = jnp.einsum('bld,dp->blp', h, w_in)
    points = [int(p) for p in np.cumsum(PROJ_SIZES)[:-1]]
    gq, gk, gv, gr, glr, nq, nk, nv = jnp.split(proj, points, axis=-1)
    y_gla = _gla_mixer(gq, gk, gv, gr, glr, gla_w_up, gla_b_up, gla_norm_w)
    y_na = _na_mixer(nq, nk, nv, na_rel_bias).astype(h.dtype)
    mix = jnp.einsum('blm,md->bld', jnp.concatenate([y_gla, y_na], axis=-1), w_out)
    h = _layer_norm(DEEPNORM_ALPHA * h + mix, ln1_w, ln1_b)
    ff = jnp.einsum('blf,fd->bld', jnp.square(jax.nn.relu(jnp.einsum('bld,df->blf', h, w_ff1))), w_ff2)
    return _layer_norm(DEEPNORM_ALPHA * h + ff, ln2_w, ln2_b)


def setup_inputs(seed: int = 0) -> dict:
    key = jax.random.key(seed)
    ks = jax.random.split(key, 14)
    nrm = jax.random.normal
    f32 = jnp.float32
    p_total = sum(PROJ_SIZES)
    return {
        "x": nrm(ks[0], (BATCH, SEQ, D_MODEL), f32),
        "meta": nrm(ks[1], (N_META, D_MODEL), f32),
        "w_in": nrm(ks[2], (DEPTH, D_MODEL, p_total), f32) * D_MODEL ** -0.5,
        "gla_w_up": nrm(ks[3], (DEPTH, 2, GLA_RANK, GLA_HEADS * GLA_DK), f32) * GLA_RANK ** -0.5,
        "gla_b_up": 0.1 * nrm(ks[4], (DEPTH, 2, GLA_HEADS * GLA_DK), f32),
        "gla_norm_w": 1.0 + 0.02 * nrm(ks[5], (DEPTH, GLA_DV), f32),
        "na_rel_bias": 0.1 * nrm(ks[6], (DEPTH, NA_HEADS, 2 * NA_WIN_H - 1, 2 * NA_WIN_W - 1), f32),
        "w_out": nrm(ks[7], (DEPTH, MIX_WIDTH, D_MODEL), f32) * (MIX_WIDTH ** -0.5 * DEEPNORM_BETA),
        "ln1_w": 1.0 + 0.02 * nrm(ks[8], (DEPTH, D_MODEL), f32),
        "ln1_b": 0.02 * nrm(ks[9], (DEPTH, D_MODEL), f32),
        "w_ff1": nrm(ks[10], (DEPTH, D_MODEL, D_FF), f32) * D_MODEL ** -0.5,
        "w_ff2": nrm(ks[11], (DEPTH, D_FF, D_MODEL), f32) * (D_FF ** -0.5 * DEEPNORM_BETA),
        "ln2_w": 1.0 + 0.02 * nrm(ks[12], (DEPTH, D_MODEL), f32),
        "ln2_b": 0.02 * nrm(ks[13], (DEPTH, D_MODEL), f32),
    }


def reference(x, meta, w_in, gla_w_up, gla_b_up, gla_norm_w, na_rel_bias, w_out,
              ln1_w, ln1_b, w_ff1, w_ff2, ln2_w, ln2_b):
    B = x.shape[0]
    meta_b = jnp.broadcast_to(meta.astype(x.dtype)[None], (B, N_META, x.shape[-1]))
    h = jnp.concatenate([meta_b, x], axis=1)
    for l in range(DEPTH):
        h = _layer(h, w_in[l], gla_w_up[l], gla_b_up[l], gla_norm_w[l], na_rel_bias[l], w_out[l],
                   ln1_w[l], ln1_b[l], w_ff1[l], w_ff2[l], ln2_w[l], ln2_b[l])
    return h[:, N_META:]
```

```cpp
#include <hip/hip_runtime.h>
#include <hip/hip_cooperative_groups.h>
#include <cstdio>
#include <cstdint>
namespace cg = cooperative_groups;
#define MK_ONE_LAUNCH 1
#define MK_REP_MASK 0
namespace pg8 {
#define PG8_LAS __attribute__((address_space(3)))
typedef unsigned short bf16_t;
typedef short bf16x8 __attribute__((ext_vector_type(8)));
typedef float f32x4 __attribute__((ext_vector_type(4)));
typedef unsigned u32x4 __attribute__((ext_vector_type(4)));
constexpr int BM = 256, BK = 64, HALF = 128, HTB = HALF * BK * 2  , STAGE_BYTES = 8 * HTB, NXCD = 8, WGM = 2;

__host__ __device__ __forceinline__ int lds_byte(int r, int c) { const int st = (r >> 4) * 2 + (c >> 5), rr = r & 15, cc = c & 31, ob = rr * 64 + cc * 2; return st * 1024 + (ob ^ (((ob >> 9) & 1) << 5)); }
__host__ __device__ __forceinline__ void stage_rc(int b, int& R, int& C) { const int st = b / 1024, sb = b % 1024, swz = sb ^ (((sb >> 9) & 1) << 5); R = (st >> 1) * 16 + swz / 64; C = (st & 1) * 32 + (swz % 64) / 2; }
__host__ __device__ __forceinline__ int perm32(int rho) { const int n = rho >> 4, i = rho & 15; return 8 * (i >> 2) + 4 * n + (i & 3); }

struct Unit { int pm, pn, k0, nt, kind; };
struct Gemm { const bf16_t* A; const bf16_t* Bt; int M, N, K; };

struct StaticOrder {
    int nM, nN, nwg, G, c, ntile;
    __host__ __device__ void init(int M, int N, int G_, int c_) { nM = M / BM; nN = N / BM; nwg = nM * nN; G = G_; c = c_; }
    __host__ __device__ bool next(int i, Unit& u) const {
        const long L = (long)i * G + c; if (L >= nwg) return false;
        int wgid = (int)L; { const int q = nwg / NXCD, r = nwg % NXCD, xcd = wgid % NXCD, off = wgid / NXCD; wgid = (xcd < r ? xcd * (q + 1) : r * (q + 1) + (xcd - r) * q) + off; }
        const int nig = WGM * nN, gid = wgid / nig, fm = gid * WGM, gsz = (nM - fm) < WGM ? (nM - fm) : WGM;
        u.pm = fm + ((wgid % nig) % gsz); u.pn = (wgid % nig) / gsz; u.k0 = 0; u.nt = ntile; u.kind = 0;
        if ((nwg % NXCD) == 0 && (nM % NXCD) == 0 && (nN % NXCD) == 0 && ((nM / NXCD) % WGM) == 0) { const int xo = (int)(L % NXCD) * (nN / NXCD); u.pn += xo; if (u.pn >= nN) u.pn -= nN; }
        return true;
    }
    __device__ __forceinline__ void a_ready(const Unit&) const {}
    __device__ __forceinline__ void done(const Unit&) const {}
};
__device__ __forceinline__ unsigned cvt_pk_bf16(float lo, float hi) { unsigned r; asm volatile("v_cvt_pk_bf16_f32 %0, %1, %2" : "=v"(r) : "v"(lo), "v"(hi)); return r; }
typedef float f32x2 __attribute__((ext_vector_type(2)));
struct EpiY {
    static constexpr bool PERM = true, AFTER_DRAIN = false;
    bf16_t* Y; int ldc; float* part;
    __device__ __forceinline__ void operator()(const f32x4 (&acc)[2][2][4][2], const Unit& u, int wr, int wc, int fr, int fq) const {
        const int col0 = u.pn * BM + wc * 32 + 8 * fq;
        if (u.kind == 0) {
            const int row0 = u.pm * BM + wr * 64 + fr;
#pragma unroll
            for (int ai = 0; ai < 2; ++ai)
#pragma unroll
                for (int m = 0; m < 4; ++m) { bf16_t* rowp = Y + (size_t)(row0 + ai * HALF + m * 16) * ldc + col0;
#pragma unroll
                    for (int bj = 0; bj < 2; ++bj) { const f32x4 v0 = acc[ai][bj][m][0], v1 = acc[ai][bj][m][1];
                        u32x4 w; w.x = cvt_pk_bf16(v0[0], v0[1]); w.y = cvt_pk_bf16(v0[2], v0[3]); w.z = cvt_pk_bf16(v1[0], v1[1]); w.w = cvt_pk_bf16(v1[2], v1[3]);
                        *(u32x4*)(rowp + bj * HALF) = w; } }
        } else if (wr == 0) {
            float* pb = part + (size_t)(u.k0 / u.nt) * 64 * ldc;
#pragma unroll
            for (int m = 0; m < 4; ++m) { float* rowp = pb + (size_t)(m * 16 + fr) * ldc + col0;
#pragma unroll
                for (int bj = 0; bj < 2; ++bj)
#pragma unroll
                    for (int n = 0; n < 2; ++n) *(f32x4*)(rowp + bj * HALF + n * 4) = acc[0][bj][m][n]; }
        }
    }
};
template <int ACT  > struct EpiBf16 {
    static constexpr bool PERM = true, AFTER_DRAIN = false;
    bf16_t* O; int ldc;
    __device__ __forceinline__ void operator()(const f32x4 (&acc)[2][2][4][2], const Unit& u, int wr, int wc, int fr, int fq) const {
        const int row0 = u.pm * BM + wr * 64 + fr; const int col0 = u.pn * BM + wc * 32 + 8 * fq;
#pragma unroll
        for (int ai = 0; ai < 2; ++ai)
#pragma unroll
            for (int m = 0; m < 4; ++m) { bf16_t* rowp = O + (size_t)(row0 + ai * HALF + m * 16) * ldc + col0;
#pragma unroll
                for (int bj = 0; bj < 2; ++bj) { f32x4 v0 = acc[ai][bj][m][0], v1 = acc[ai][bj][m][1];
                    if (ACT == 1) {
#pragma unroll
                        for (int j = 0; j < 4; ++j) { const float a = fmaxf(v0[j], 0.f), b = fmaxf(v1[j], 0.f); v0[j] = a * a; v1[j] = b * b; } }
                    u32x4 w; w.x = cvt_pk_bf16(v0[0], v0[1]); w.y = cvt_pk_bf16(v0[2], v0[3]); w.z = cvt_pk_bf16(v1[0], v1[1]); w.w = cvt_pk_bf16(v1[2], v1[3]);
                    *(u32x4*)(rowp + bj * HALF) = w; } }
    }
};
template <class Epi, class Sched, bool ALIGN_EPI = false, bool SP2 = false>
__device__ __forceinline__ void gemm_phase(PG8_LAS unsigned char* lds, const Gemm g, const Sched& S, const Epi& E) {
    int tid = threadIdx.x; asm volatile("" : "+v"(tid));
    const int wid = __builtin_amdgcn_readfirstlane(tid >> 6), lane = tid & 63, wr = wid >> 2, wc = wid & 3, fr = lane & 15, fq = lane >> 4;
    const int K = g.K;
    unsigned voffA[2], voffB[2];
#pragma unroll
    for (int i = 0; i < 2; ++i) { int R, C; stage_rc(tid * 16 + i * 8192, R, C); const int Rb = Epi::PERM ? ((R & ~31) + perm32(R & 31)) : R;
        voffA[i] = (unsigned)(R * K + C) * 2u; voffB[i] = (unsigned)(Rb * K + C) * 2u; }
    const size_t kstep = (size_t)(BK * 2);
    const size_t hstep = (size_t)HALF * K * 2;
    const size_t tstep = 2 * hstep;
    const unsigned ldsw = (unsigned)wid * 1024u;
    const int aoff = lds_byte(wr * 64 + fr, fq * 8), boff = lds_byte(wc * 32 + fr, fq * 8);
#define PG8_SA(b, h) (((b) * 2 + (h)) * HTB)
#define PG8_SB(b, h) ((4 + (b) * 2 + (h)) * HTB)
#define PG8_STAGE(bufoff, gbase, voff) do { _Pragma("unroll") for (int _i = 0; _i < 2; ++_i) \
        __builtin_amdgcn_global_load_lds((const unsigned*)((const char*)(gbase) + (voff)[_i]), (PG8_LAS unsigned*)(lds + (bufoff) + ldsw + _i * 8192), 16, 0, 0); } while (0)
#define PG8_LDA(dst, b, h) do { _Pragma("unroll") for (int m = 0; m < 4; ++m) _Pragma("unroll") for (int k = 0; k < 2; ++k) dst[m][k] = *(const PG8_LAS bf16x8*)(lds + PG8_SA(b, h) + aoff + m * 2048 + k * 1024); } while (0)
#define PG8_LDB(dst, b, h) do { _Pragma("unroll") for (int n = 0; n < 2; ++n) _Pragma("unroll") for (int k = 0; k < 2; ++k) dst[n][k] = *(const PG8_LAS bf16x8*)(lds + PG8_SB(b, h) + boff + n * 2048 + k * 1024); } while (0)
#define PG8_MMA(ai, bj, At, Bt) do { __builtin_amdgcn_s_setprio(1); _Pragma("unroll") for (int m = 0; m < 4; ++m) _Pragma("unroll") for (int n = 0; n < 2; ++n) _Pragma("unroll") for (int k = 0; k < 2; ++k) \
        acc[ai][bj][m][n] = __builtin_amdgcn_mfma_f32_16x16x32_bf16(Bt[n][k], At[m][k], acc[ai][bj][m][n], 0, 0, 0); __builtin_amdgcn_s_setprio(0); } while (0)
#define PG8_WAIT_V(n) asm volatile("s_waitcnt vmcnt(" #n ")" ::: "memory")
#define PG8_WAIT_L(n) asm volatile("s_waitcnt lgkmcnt(" #n ")" ::: "memory")
#define PG8_BAR __builtin_amdgcn_s_barrier()
#define PG8_SCHED __builtin_amdgcn_sched_barrier(0)
    Unit cur, nxt; int ui = 0;
    if (!S.next(0, cur)) return;
    f32x4 acc[2][2][4][2];
#pragma unroll
    for (int a = 0; a < 2; ++a)
#pragma unroll
        for (int b = 0; b < 2; ++b)
#pragma unroll
            for (int m = 0; m < 4; ++m)
#pragma unroll
                for (int n = 0; n < 2; ++n) acc[a][b][m][n] = (f32x4){0.f, 0.f, 0.f, 0.f};
    bf16x8 At[4][2], B0[2][2], B1[2][2];
    const char* cA = (const char*)g.A + (size_t)cur.pm * tstep + (size_t)cur.k0 * kstep; const char* cB = (const char*)g.Bt + (size_t)cur.pn * tstep + (size_t)cur.k0 * kstep;
    S.a_ready(cur);
    if constexpr (SP2) {
        PG8_STAGE(PG8_SB(0, 0), cB, voffB); PG8_STAGE(PG8_SB(0, 1), cB + hstep, voffB); PG8_STAGE(PG8_SA(0, 0), cA, voffA); PG8_STAGE(PG8_SA(0, 1), cA + hstep, voffA);
        if (wr == 1) PG8_BAR;
        PG8_WAIT_V(2); PG8_BAR;
        PG8_STAGE(PG8_SB(1, 0), cB + kstep, voffB); PG8_STAGE(PG8_SA(1, 0), cA + kstep, voffA); PG8_STAGE(PG8_SB(1, 1), cB + hstep + kstep, voffB);
        PG8_WAIT_V(6); PG8_BAR;
    } else {
        PG8_STAGE(PG8_SB(0, 0), cB, voffB); PG8_STAGE(PG8_SA(0, 0), cA, voffA); PG8_STAGE(PG8_SB(0, 1), cB + hstep, voffB); PG8_STAGE(PG8_SA(0, 1), cA + hstep, voffA);
        if (wr == 1) PG8_BAR;
        PG8_WAIT_V(4); PG8_BAR;
        PG8_STAGE(PG8_SB(1, 0), cB + kstep, voffB); PG8_STAGE(PG8_SA(1, 0), cA + kstep, voffA); PG8_STAGE(PG8_SB(1, 1), cB + hstep + kstep, voffB);
        PG8_WAIT_V(6); PG8_BAR;
    }
    for (;;) {
        const bool has_next = S.next(ui + 1, nxt);
        const char* nA = has_next ? (const char*)g.A + (size_t)nxt.pm * tstep + (size_t)nxt.k0 * kstep : cA; const char* nB = has_next ? (const char*)g.Bt + (size_t)nxt.pn * tstep + (size_t)nxt.k0 * kstep : cB;
        const int nt = cur.nt;
        for (int t = 0; t < nt; t += 2) {
            const bool last = (t == nt - 2);
            const char* a1 = cA + (size_t)(t + 1) * kstep;
            const char* a2 = last ? nA : cA + (size_t)(t + 2) * kstep; const char* b2 = last ? nB : cB + (size_t)(t + 2) * kstep;
            const char* a3 = a2 + kstep; const char* b3 = b2 + kstep;
            if (last && has_next) S.a_ready(nxt);
            if constexpr (SP2) {
            PG8_LDB(B0, 0, 0); PG8_LDB(B1, 0, 1); PG8_SCHED; PG8_LDA(At, 0, 0); PG8_STAGE(PG8_SA(1, 1), a1 + hstep, voffA);
            PG8_WAIT_V(8); PG8_WAIT_L(0); PG8_BAR; PG8_MMA(0, 0, At, B0); PG8_MMA(0, 1, At, B1); PG8_BAR; PG8_SCHED;
            PG8_LDA(At, 0, 1); PG8_STAGE(PG8_SB(0, 0), b2, voffB); PG8_STAGE(PG8_SB(0, 1), b2 + hstep, voffB); PG8_STAGE(PG8_SA(0, 0), a2, voffA);
            PG8_WAIT_V(8); PG8_WAIT_L(0); PG8_BAR; PG8_MMA(1, 0, At, B0); PG8_MMA(1, 1, At, B1); PG8_BAR; PG8_SCHED;
            PG8_LDB(B0, 1, 0); PG8_LDB(B1, 1, 1); PG8_SCHED; PG8_LDA(At, 1, 0); PG8_STAGE(PG8_SA(0, 1), a2 + hstep, voffA);
            PG8_WAIT_V(8); PG8_WAIT_L(0); PG8_BAR; PG8_MMA(0, 0, At, B0); PG8_MMA(0, 1, At, B1); PG8_BAR; PG8_SCHED;
            PG8_LDA(At, 1, 1); PG8_STAGE(PG8_SB(1, 0), b3, voffB); PG8_STAGE(PG8_SB(1, 1), b3 + hstep, voffB); PG8_STAGE(PG8_SA(1, 0), a3, voffA);
            PG8_WAIT_V(8); PG8_WAIT_L(0); PG8_BAR; PG8_MMA(1, 0, At, B0); PG8_MMA(1, 1, At, B1); PG8_BAR; PG8_SCHED;
            } else {
            PG8_LDB(B0, 0, 0); PG8_SCHED; PG8_LDA(At, 0, 0); PG8_STAGE(PG8_SA(1, 1), a1 + hstep, voffA);
            PG8_WAIT_L(8); PG8_BAR; PG8_WAIT_L(0); PG8_MMA(0, 0, At, B0); PG8_BAR; PG8_SCHED;
            PG8_LDB(B1, 0, 1); PG8_STAGE(PG8_SB(0, 0), b2, voffB);
            PG8_BAR; PG8_WAIT_L(0); PG8_MMA(0, 1, At, B1); PG8_BAR;
            PG8_LDA(At, 0, 1); PG8_STAGE(PG8_SA(0, 0), a2, voffA);
            PG8_BAR; PG8_WAIT_L(0); PG8_MMA(1, 0, At, B0); PG8_BAR; PG8_SCHED;
            PG8_STAGE(PG8_SB(0, 1), b2 + hstep, voffB);
            PG8_WAIT_V(6); PG8_BAR; PG8_MMA(1, 1, At, B1); PG8_BAR;
            PG8_LDB(B0, 1, 0); PG8_SCHED; PG8_LDA(At, 1, 0); PG8_STAGE(PG8_SA(0, 1), a2 + hstep, voffA);
            PG8_WAIT_L(8); PG8_BAR; PG8_WAIT_L(0); PG8_MMA(0, 0, At, B0); PG8_BAR; PG8_SCHED;
            PG8_LDB(B1, 1, 1); PG8_STAGE(PG8_SB(1, 0), b3, voffB);
            PG8_BAR; PG8_WAIT_L(0); PG8_MMA(0, 1, At, B1); PG8_BAR;
            PG8_LDA(At, 1, 1); PG8_STAGE(PG8_SA(1, 0), a3, voffA);
            PG8_BAR; PG8_WAIT_L(0); PG8_MMA(1, 0, At, B0); PG8_BAR; PG8_SCHED;
            PG8_STAGE(PG8_SB(1, 1), b3 + hstep, voffB);
            PG8_WAIT_V(6); PG8_BAR; PG8_MMA(1, 1, At, B1); PG8_BAR;
            }
        }
        if constexpr (ALIGN_EPI) { if (wr == 0) PG8_BAR; }
        if constexpr (!Epi::AFTER_DRAIN) { E(acc, cur, wr, wc, fr, fq); S.done(cur); }
        if (!has_next) break;
#pragma unroll
        for (int a = 0; a < 2; ++a)
#pragma unroll
            for (int b = 0; b < 2; ++b)
#pragma unroll
                for (int m = 0; m < 4; ++m)
#pragma unroll
                    for (int n = 0; n < 2; ++n) acc[a][b][m][n] = (f32x4){0.f, 0.f, 0.f, 0.f};
        cur = nxt; cA = nA; cB = nB; ++ui;
        if constexpr (ALIGN_EPI) { if (wr == 1) PG8_BAR; }
    }
    PG8_WAIT_V(0);
    if constexpr (!ALIGN_EPI) { if (wr == 0) PG8_BAR; }
    PG8_BAR;
    if constexpr (Epi::AFTER_DRAIN) { E.fused(acc, cur, wr, wc, fr, fq, lds, wid, lane); S.done(cur); }
#undef PG8_SA
#undef PG8_SB
#undef PG8_STAGE
#undef PG8_LDA
#undef PG8_LDB
#undef PG8_MMA
#undef PG8_WAIT_V
#undef PG8_WAIT_L
#undef PG8_BAR
#undef PG8_SCHED
}
}
#define LAS __attribute__((address_space(3)))
#define XB_TMO      128
#define XB_XCNT(j)  (256  + 64 * (j))
#define XB_XSUB(j)  (1280 + 64 * (j))
#define XB_XGEN(j)  (2304 + 64 * (j))
#define XB_TOP      3328
#define XB_TOPGEN   3392
#define XCD_BAR_WORDS 3456
#define XB_SPIN_CAP (1u << 18)

__device__ __forceinline__ unsigned xb_ld(unsigned* p)              { return __hip_atomic_load(p, __ATOMIC_RELAXED, __HIP_MEMORY_SCOPE_AGENT); }
__device__ __forceinline__ unsigned xb_add(unsigned* p, unsigned v) { return __hip_atomic_fetch_add(p, v, __ATOMIC_RELAXED, __HIP_MEMORY_SCOPE_AGENT); }
__device__ __forceinline__ unsigned xb_xcc_id() { return (unsigned)__builtin_amdgcn_s_getreg((3 << 11) | 20) & 0xFu; }
#define XB_SPIN(cond, bar) do { unsigned _sp = 0; while (cond) { __builtin_amdgcn_s_sleep(1); \
    if ((++_sp & 255u) == 0u) { if (xb_ld(&(bar)[XB_TMO])) break; if (_sp > XB_SPIN_CAP) { atomicAdd(&(bar)[XB_TMO], 1u); break; } } } } while (0)

struct XcdBarrier {
    unsigned* bar; unsigned x;
    volatile LAS unsigned* st;
};

__device__ __forceinline__ XcdBarrier xcd_barrier_post(unsigned* bar, volatile LAS unsigned* st) {
    XcdBarrier b; b.bar = bar; b.x = xb_xcc_id(); b.st = st;
    if (threadIdx.x == 0) (void)xb_add(&bar[XB_XCNT(b.x)], 1u);
    return b;
}
__device__ __forceinline__ void xcd_barrier_complete(unsigned* bar, unsigned x, unsigned& nloc, unsigned& nx) {
    const unsigned G = gridDim.x * gridDim.y * gridDim.z;
    unsigned sum, cnt, mine, sp = 0u;
    for (;;) {
        sum = 0u; cnt = 0u; mine = 0u;
#pragma unroll
        for (unsigned j = 0; j < 16; ++j) { const unsigned c = xb_ld(&bar[XB_XCNT(j)]); sum += c; cnt += (c > 0u) ? 1u : 0u; mine = (j == x) ? c : mine; }
        if (sum == G) break;
        __builtin_amdgcn_s_sleep(1);
        if ((++sp & 255u) == 0u) { if (xb_ld(&bar[XB_TMO])) break; if (sp > XB_SPIN_CAP) { atomicAdd(&bar[XB_TMO], 1u); break; } }
    }
    nloc = mine > 0u ? mine : 1u; nx = cnt > 0u ? cnt : 1u;
}

__device__ __forceinline__ void xcd_barrier(const XcdBarrier& b) {
    asm volatile("s_waitcnt vmcnt(0)" ::: "memory");
    __syncthreads();
    if (threadIdx.x == 0) {
        unsigned* bar = b.bar;
        __builtin_amdgcn_s_waitcnt(0);
        unsigned nloc = b.st[0], nx = b.st[1];
        if (nloc == 0u) { xcd_barrier_complete(bar, b.x, nloc, nx); b.st[0] = nloc; b.st[1] = nx; }
        const unsigned old = xb_add(&bar[XB_XSUB(b.x)], 1u);
        const unsigned gen = old / nloc;
        if (old + 1u == (gen + 1u) * nloc) {
            __builtin_amdgcn_fence(__ATOMIC_RELEASE, "agent");
            asm volatile("s_waitcnt vmcnt(0)" ::: "memory");
            const unsigned og = xb_add(&bar[XB_TOP], 1u);
            const unsigned tg = og / nx;
            if (og + 1u == (tg + 1u) * nx) xb_add(&bar[XB_TOPGEN], 1u);
            else XB_SPIN(xb_ld(&bar[XB_TOPGEN]) == tg, bar);
            __builtin_amdgcn_fence(__ATOMIC_ACQUIRE, "agent");
            xb_add(&bar[XB_XGEN(b.x)], 1u);
            asm volatile("s_waitcnt vmcnt(0)" ::: "memory");
        } else {
            XB_SPIN(xb_ld(&bar[XB_XGEN(b.x)]) == gen, bar);
            __builtin_amdgcn_fence(__ATOMIC_ACQUIRE, "agent");
            asm volatile("s_waitcnt vmcnt(0)" ::: "memory");
        }
    }
    __syncthreads();
}


typedef unsigned short bf16_t;
typedef float f32x4_t __attribute__((ext_vector_type(4)));


constexpr int NB = 4, TT = 2048, NMETA = 16, LL = 2064, DM = 2048, MTOK = NB * LL  , MPAD = 8448, PP = 6176, PPAD = 6400, DFF = 8192;
constexpr int GQ = 0, GK = 512, GV = 1024, GR = 2048, NQ = 3072, NK = 4096, NV = 5120, LR = 6144;
constexpr int NLAYER = 2;
constexpr int LDS_BYTES = 163840;
constexpr float DN_ALPHA = 1.41421356237f;
constexpr float LN_EPS = 1e-5f;

constexpr size_t SZ_WT_IN = (size_t)PPAD * DM * 2, SZ_WT_OUT = (size_t)DM * DM * 2, SZ_WT_FF = (size_t)DFF * DM * 2;
constexpr size_t WS_WT_IN = 0, WS_WT_OUT = WS_WT_IN + NLAYER * SZ_WT_IN, WS_WT_FF1 = WS_WT_OUT + NLAYER * SZ_WT_OUT, WS_WT_FF2 = WS_WT_FF1 + NLAYER * SZ_WT_FF;
constexpr size_t WS_HRES = WS_WT_FF2 + NLAYER * SZ_WT_FF;
constexpr size_t WS_ACTB = WS_HRES + (size_t)MPAD * DM * 4;
constexpr size_t WS_R = WS_ACTB + (size_t)MPAD * DM * 2;
constexpr size_t WS_PROJ = WS_R;
constexpr int LPAD = 2112, NCHK = 33;
constexpr size_t SZ_QT = (size_t)2 * NB * LPAD * 512 * 2;
constexpr size_t WS_QT = WS_HRES + (size_t)MPAD * DM * 2, WS_KT = WS_QT + SZ_QT;
static_assert(2 * SZ_QT <= (size_t)MPAD * DM * 2, "qt/kt overlay");
constexpr size_t WS_KTT = WS_PROJ + (size_t)MPAD * PPAD * 2;
constexpr size_t WS_EBL = WS_KTT + SZ_QT;
constexpr size_t WS_VT = WS_EBL + (size_t)2 * NB * NCHK * 512 * 4;
constexpr size_t WS_OF = WS_VT + (size_t)NB * 16 * 64 * LPAD * 2;
constexpr size_t WS_OB = WS_OF + (size_t)MTOK * 1024 * 4;
constexpr size_t WS_HID = WS_R;
constexpr size_t WS_Y = WS_HID + (size_t)MPAD * DFF * 2;
constexpr size_t WS_END0 = WS_Y + (size_t)MPAD * DM * 4, WS_END1 = WS_OB + (size_t)MTOK * 1024 * 4;
constexpr size_t WS_END = WS_END0 > WS_END1 ? WS_END0 : WS_END1;
constexpr int NSEG_OUT = 16, NSEG_FF2 = 32;
constexpr size_t WS_PART = WS_END0;
constexpr size_t WS_END2 = WS_PART + (size_t)NSEG_FF2 * 64 * DM * 4;
constexpr size_t WS_BAR = ((WS_END > WS_END2 ? WS_END : WS_END2) + 255) / 256 * 256;
constexpr size_t WS_TOTAL = WS_BAR + (size_t)XCD_BAR_WORDS * 4;
static_assert(WS_TOTAL <= (size_t)536870912, "workspace budget");

struct Params {
    const float *x, *meta, *w_in, *w_up, *b_up, *gnorm, *relb, *w_out, *ln1w, *ln1b, *w_ff1, *w_ff2, *ln2w, *ln2b;
    float* out;
    unsigned char* ws;
    int ph_lo, ph_hi, coop, pad;
};

__device__ __forceinline__ int opaque_tid() { int t = threadIdx.x; asm volatile("" : "+v"(t)); return t; }
__device__ __forceinline__ int opaque_bid() { int t = blockIdx.x; asm volatile("" : "+s"(t)); return t; }
__device__ __forceinline__ int xcd_vbid() { const int b = opaque_bid(), G = (int)gridDim.x; return (G & 7) ? b : (b & 7) * (G >> 3) + (b >> 3); }
__device__ __forceinline__ float bf_lo(unsigned u) { return __uint_as_float(u << 16); }
__device__ __forceinline__ float bf_hi(unsigned u) { return __uint_as_float(u & 0xffff0000u); }
__device__ __forceinline__ float bf1(bf16_t u) { return __uint_as_float(((unsigned)u) << 16); }
__device__ __forceinline__ unsigned pk2(float lo, float hi) { return pg8::cvt_pk_bf16(lo, hi); }
__device__ __forceinline__ float wave_sum(float v) {
#pragma unroll
    for (int o = 1; o < 64; o <<= 1) v += __shfl_xor(v, o);
    return v;
}

__device__ __forceinline__ void ph_prologue(const Params& p, unsigned char* smem) {
    float* tile = (float*)smem;
    constexpr int I_IN = (PPAD / 256) * (DM / 64), I_OUT = (DM / 256) * (DM / 64), I_FF1 = (DFF / 256) * (DM / 64), I_FF2 = (DM / 256) * (DFF / 64);
    constexpr int I_LAYER = I_IN + I_OUT + I_FF1 + I_FF2, I_TOT = NLAYER * I_LAYER;
    {
        const int t = opaque_tid(), n = t & 255, kk = t >> 8, kc = t & 7, nb = t >> 3, G = gridDim.x;
        const float* w = nullptr; bf16_t* wT = nullptr; int N = 0, K = 0, k0 = 0, n0 = 0, mode = 0;
        auto decode = [&](int it) {
            const int layer = it / I_LAYER; int r = it % I_LAYER;
            if (r < I_IN) { const int nt = PPAD / 256; w = p.w_in + (size_t)layer * DM * PP; N = PP; K = DM; k0 = (r / nt) * 64; n0 = (r % nt) * 256; wT = (bf16_t*)(p.ws + WS_WT_IN + layer * SZ_WT_IN); mode = 1; return; }
            r -= I_IN;
            if (r < I_OUT) { const int nt = DM / 256; w = p.w_out + (size_t)layer * DM * DM; N = DM; K = DM; k0 = (r / nt) * 64; n0 = (r % nt) * 256; wT = (bf16_t*)(p.ws + WS_WT_OUT + layer * SZ_WT_OUT); mode = 0; return; }
            r -= I_OUT;
            if (r < I_FF1) { const int nt = DFF / 256; w = p.w_ff1 + (size_t)layer * DM * DFF; N = DFF; K = DM; k0 = (r / nt) * 64; n0 = (r % nt) * 256; wT = (bf16_t*)(p.ws + WS_WT_FF1 + layer * SZ_WT_FF); mode = 0; return; }
            r -= I_FF1;
            { const int nt = DM / 256; w = p.w_ff2 + (size_t)layer * DFF * DM; N = DM; K = DFF; k0 = (r / nt) * 64; n0 = (r % nt) * 256; wT = (bf16_t*)(p.ws + WS_WT_FF2 + layer * SZ_WT_FF); mode = 0; }
        };
        float v[32];
#define CV_LOAD() { const int jn = n0 + n; int src = jn; if (mode == 1) src = jn < 3072 ? jn : (jn < 6144 ? jn + 32 : (jn < 6176 ? jn - 3072 : -1)); \
            _Pragma("unroll") for (int i = 0; i < 32; ++i) v[i] = src >= 0 ? __builtin_nontemporal_load(&w[(size_t)(k0 + kk + 2 * i) * N + src]) : 0.f; }
        int it = opaque_bid();
        if (it < I_TOT) { decode(it); CV_LOAD() }
        while (it < I_TOT) {
#pragma unroll
            for (int i = 0; i < 32; ++i) tile[(kk + 2 * i) * 257 + n] = v[i];
            __syncthreads();
            bf16_t* cwT = wT; const int cK = K, ck0 = k0, cn0 = n0;
            const int itn = it + G;
            if (itn < I_TOT) { decode(itn); CV_LOAD() }
#pragma unroll
            for (int i = 0; i < 4; ++i) { const int nn = nb + 64 * i; const float* tp = tile + (kc * 8) * 257 + nn;
                uint4 o; o.x = pk2(tp[0], tp[257]); o.y = pk2(tp[2 * 257], tp[3 * 257]); o.z = pk2(tp[4 * 257], tp[5 * 257]); o.w = pk2(tp[6 * 257], tp[7 * 257]);
                *(uint4*)(cwT + (size_t)(cn0 + nn) * cK + ck0 + kc * 8) = o; }
            __syncthreads();
            it = itn;
        }
#undef CV_LOAD
    }
    bf16_t* hres = (bf16_t*)(p.ws + WS_HRES); bf16_t* actb = (bf16_t*)(p.ws + WS_ACTB);
    const int c4 = opaque_tid() * 4;
    for (int row = opaque_bid(); row < MPAD; row += gridDim.x) {
        f32x4_t v = (f32x4_t){0.f, 0.f, 0.f, 0.f};
        if (row < MTOK) { const int b = row / LL, l = row % LL;
            const float* src = l < NMETA ? p.meta + (size_t)l * DM : p.x + ((size_t)b * TT + (l - NMETA)) * DM;
            v = *(const f32x4_t*)(src + c4); }
        uint2 o; o.x = pk2(v[0], v[1]); o.y = pk2(v[2], v[3]);
        *(uint2*)(hres + (size_t)row * DM + c4) = o;
    }
}

__device__ __forceinline__ void ph_gla_combine(const Params& p, int layer) {
    const bf16_t* proj = (const bf16_t*)(p.ws + WS_PROJ);
    const bf16_t* of = (const bf16_t*)(p.ws + WS_OF); const bf16_t* ob = (const bf16_t*)(p.ws + WS_OB);
    bf16_t* mix = (bf16_t*)(p.ws + WS_ACTB);
    const float* gn = p.gnorm + layer * 256;
    const int tid_ = opaque_tid(), lane = tid_ & 63, wv = tid_ >> 6;
    const f32x4_t g4 = *(const f32x4_t*)(gn + lane * 4);
    for (int row = opaque_bid() * 8 + wv; row < MTOK; row += gridDim.x * 8) {
        uint2 a[4], bb[4]; uint2 rr[4];
#pragma unroll
        for (int h = 0; h < 4; ++h) { a[h] = *(const uint2*)(of + (size_t)row * 1024 + h * 256 + lane * 4); bb[h] = *(const uint2*)(ob + (size_t)row * 1024 + h * 256 + lane * 4);
            rr[h] = *(const uint2*)(proj + (size_t)row * PPAD + GR + h * 256 + lane * 4); }
        __builtin_amdgcn_sched_barrier(0);
#pragma unroll
        for (int h = 0; h < 4; ++h) {
            const f32x4_t o = (f32x4_t){bf_lo(a[h].x) + bf_lo(bb[h].x), bf_hi(a[h].x) + bf_hi(bb[h].x), bf_lo(a[h].y) + bf_lo(bb[h].y), bf_hi(a[h].y) + bf_hi(bb[h].y)};
            const float ss = wave_sum(o[0] * o[0] + o[1] * o[1] + o[2] * o[2] + o[3] * o[3]);
            const float rstd = 1.0f / sqrtf(ss * (1.f / 256.f) + LN_EPS);
            const float r0 = bf_lo(rr[h].x), r1 = bf_hi(rr[h].x), r2 = bf_lo(rr[h].y), r3 = bf_hi(rr[h].y);
            const float y0 = o[0] * rstd * g4[0] * (r0 / (1.f + __expf(-r0))), y1 = o[1] * rstd * g4[1] * (r1 / (1.f + __expf(-r1)));
            const float y2 = o[2] * rstd * g4[2] * (r2 / (1.f + __expf(-r2))), y3 = o[3] * rstd * g4[3] * (r3 / (1.f + __expf(-r3)));
            uint2 w; w.x = pk2(y0, y1); w.y = pk2(y2, y3);
            *(uint2*)(mix + (size_t)row * DM + h * 256 + lane * 4) = w;
        }
    }
}

typedef short bf16x8_t __attribute__((ext_vector_type(8)));
__device__ __forceinline__ bf16_t f2bf(float x) { return (bf16_t)(pk2(x, 0.f) & 0xffffu); }
__device__ __forceinline__ void ph_gla_prep(const Params& p, int layer, unsigned char* smem) {
    const bf16_t* proj = (const bf16_t*)(p.ws + WS_PROJ);
    bf16_t* QT = (bf16_t*)(p.ws + WS_QT); bf16_t* KT = (bf16_t*)(p.ws + WS_KT); bf16_t* KTT = (bf16_t*)(p.ws + WS_KTT); float* EBL = (float*)(p.ws + WS_EBL);
    const float* w_up = p.w_up + (size_t)layer * 2 * 16 * 512; const float* b_up = p.b_up + (size_t)layer * 2 * 512;
    const int tid = opaque_tid(), d = tid & 127, tq = tid >> 7;
    float* lr_s = (float*)smem; float* part = lr_s + 1024;
    for (int item = opaque_bid(); item < 2 * NB * NCHK * 4; item += gridDim.x) {
        const int h = item & 3; int r_ = item >> 2; const int c = r_ % NCHK; r_ /= NCHK; const int b = r_ & 3, dir = r_ >> 2;
        __syncthreads();
        { const int t = tid >> 3, rr = (tid & 7) * 2; const int s = c * 64 + t; const bool val = s < LL; const int l = val ? (dir ? (LL - 1 - s) : s) : 0;
          const unsigned u = *(const unsigned*)(proj + (size_t)(b * LL + l) * PPAD + LR + dir * 16 + rr);
          lr_s[t * 16 + rr] = bf_lo(u); lr_s[t * 16 + rr + 1] = bf_hi(u); }
        bf16_t qraw[16], kraw[16];
#pragma unroll
        for (int i = 0; i < 16; ++i) { const int s = c * 64 + tq * 16 + i; const bool val = s < LL; const int l = val ? (dir ? (LL - 1 - s) : s) : 0;
            const bf16_t* rp = proj + (size_t)(b * LL + l) * PPAD; qraw[i] = rp[GQ + h * 128 + d]; kraw[i] = rp[GK + h * 128 + d]; }
        float wup[16];
#pragma unroll
        for (int r = 0; r < 16; ++r) wup[r] = w_up[(size_t)(dir * 16 + r) * 512 + h * 128 + d];
        const float bu = b_up[dir * 512 + h * 128 + d];
        __syncthreads();
        float g[16]; float run = 0.f;
#pragma unroll
        for (int i = 0; i < 16; ++i) { const int t = tq * 16 + i, s = c * 64 + t;
            float z = bu;
#pragma unroll
            for (int r4 = 0; r4 < 4; ++r4) { const f32x4_t v = *(const f32x4_t*)(lr_s + t * 16 + r4 * 4);
                z += v[0] * wup[r4 * 4 + 0] + v[1] * wup[r4 * 4 + 1] + v[2] * wup[r4 * 4 + 2] + v[3] * wup[r4 * 4 + 3]; }
            const float ls = fminf(z, 0.f) - __logf(1.f + __expf(-fabsf(z)));
            run += (s < LL) ? ls * 0.0625f : 0.f; g[i] = run; }
        part[tq * 128 + d] = run;
        __syncthreads();
        float off = 0.f, tot = 0.f;
#pragma unroll
        for (int q = 0; q < 4; ++q) { const float pv = part[q * 128 + d]; off += (q < tq) ? pv : 0.f; tot += pv; }
        const size_t seqrow = (size_t)(dir * NB + b) * LPAD;
        unsigned kt_pk[8];
#pragma unroll
        for (int i = 0; i < 16; ++i) { const int t = tq * 16 + i, s = c * 64 + t; const bool val = s < LL; const int l = val ? (dir ? (LL - 1 - s) : s) : 0;
            const float qv = val ? bf1(qraw[i]) : 0.f, kv = val ? bf1(kraw[i]) : 0.f;
            const float bc = off + g[i];
            const float qd = qv * 0.08838834764831845f * __expf(bc), kd = kv * __expf(-bc);
            QT[(seqrow + s) * 512 + h * 128 + d] = f2bf(qd);
            const bf16_t kb = f2bf(kd);
            KT[(seqrow + s) * 512 + h * 128 + d] = kb;
            if (i & 1) kt_pk[i >> 1] |= ((unsigned)kb) << 16; else kt_pk[i >> 1] = kb; }
        { bf16_t* kp = KTT + ((((size_t)(dir * NB + b) * NCHK + c) * 4 + h) * 128 + d) * 64 + tq * 16;
          *(uint4*)(kp) = make_uint4(kt_pk[0], kt_pk[1], kt_pk[2], kt_pk[3]); *(uint4*)(kp + 8) = make_uint4(kt_pk[4], kt_pk[5], kt_pk[6], kt_pk[7]); }
        if (tq == 0) EBL[((size_t)(dir * NB + b) * NCHK + c) * 512 + h * 128 + d] = __expf(tot);
    }
}

__device__ __forceinline__ void ph_vt(const Params& p, unsigned char* smem) {
    const bf16_t* proj = (const bf16_t*)(p.ws + WS_PROJ); bf16_t* VT = (bf16_t*)(p.ws + WS_VT);
    const int tid = opaque_tid();
    bf16_t* T = (bf16_t*)smem;
    typedef unsigned u32x4_t __attribute__((ext_vector_type(4)));
    constexpr int NIT = NB * 16 * NCHK;
    for (int base = opaque_bid() * 4; base < NIT; base += gridDim.x * 4) {
        u32x4_t u[4];
#pragma unroll
        for (int i = 0; i < 4; ++i) { const int item = min(base + i, NIT - 1), tb = item % NCHK, bh = item / NCHK, h = bh & 15, b = bh >> 4;
            const int tok = tid >> 3, c = tid & 7, l = min(tb * 64 + tok, LL - 1);
            u[i] = *(const u32x4_t*)(proj + (size_t)(b * LL + l) * PPAD + NV + h * 64 + c * 8); }
        __builtin_amdgcn_sched_barrier(0);
        __syncthreads();
#pragma unroll
        for (int i = 0; i < 4; ++i) { const int item = min(base + i, NIT - 1), tb = item % NCHK;
            const int tok = tid >> 3, c = tid & 7;
            const u32x4_t v = (tb * 64 + tok < LL) ? u[i] : (u32x4_t){0u, 0u, 0u, 0u};
            bf16_t* tp = T + i * (64 * 72) + (c * 8) * 72 + tok;
            tp[0 * 72] = (bf16_t)(v.x & 0xffffu); tp[1 * 72] = (bf16_t)(v.x >> 16); tp[2 * 72] = (bf16_t)(v.y & 0xffffu); tp[3 * 72] = (bf16_t)(v.y >> 16);
            tp[4 * 72] = (bf16_t)(v.z & 0xffffu); tp[5 * 72] = (bf16_t)(v.z >> 16); tp[6 * 72] = (bf16_t)(v.w & 0xffffu); tp[7 * 72] = (bf16_t)(v.w >> 16); }
        __syncthreads();
#pragma unroll
        for (int i = 0; i < 4; ++i) { const int item = base + i;
            if (item < NIT) { const int tb = item % NCHK, bh = item / NCHK, h = bh & 15, b = bh >> 4;
                const int dh = tid & 63, c = tid >> 6;
                *(uint4*)(VT + (((size_t)(b * 16 + h) * (LPAD / 8) + tb * 8 + c) * 64 + dh) * 8) = *(const uint4*)(T + i * (64 * 72) + dh * 72 + c * 8); } }
    }
}

__device__ __forceinline__ void ph_gla_scan2(const Params& p, int layer, unsigned char* smem) {
    const bf16_t* proj = (const bf16_t*)(p.ws + WS_PROJ);
    const bf16_t* QT = (const bf16_t*)(p.ws + WS_QT); const bf16_t* KT = (const bf16_t*)(p.ws + WS_KT); const bf16_t* KTT = (const bf16_t*)(p.ws + WS_KTT); const float* EBL = (const float*)(p.ws + WS_EBL);
    const int tid = opaque_tid(), lane = tid & 63, w = tid >> 6, fr = lane & 15, g = lane >> 4;
    constexpr int QS = 272, TS = 144;
    constexpr int OFF_Q = 0, OFF_K = 64 * QS, OFF_KT = 2 * 64 * QS, OFF_VT = OFF_KT + 128 * TS, BUFB = OFF_VT + 32 * TS;
    constexpr int OFF_A = 2 * BUFB, OFF_ST = OFF_A + 64 * TS, LDS_END = OFF_ST + 32 * QS;
    static_assert(LDS_END <= LDS_BYTES, "lds");
    const int tt = w >> 1, eo = w & 1;
    for (int item = xcd_vbid(); item < 256; item += gridDim.x) {
        const int slice = item & 7, seq = item >> 3, dir = seq & 1, h = (seq >> 1) & 3, b = seq >> 3;
        bf16_t* outp = (bf16_t*)(p.ws + (dir ? WS_OB : WS_OF));
        const size_t seqrow = (size_t)(dir * NB + b) * LPAD;
        __syncthreads();
        for (int i = tid; i < (64 * TS + 32 * QS) / 4; i += 512) ((unsigned*)(smem + OFF_A))[i] = 0u;
        uint4 ra_q0, ra_q1, ra_k0, ra_k1, ra_kt0, ra_kt1, ra_v, rb_q0, rb_q1, rb_k0, rb_k1, rb_kt0, rb_kt1, rb_v; f32x4_t ra_eb, rb_eb;
        const int srow0 = tid >> 4, srow1 = (tid + 512) >> 4, sc16 = tid & 15;
#define SC_ISSUE(R, c_) do { const int cc_ = min((c_), NCHK - 1);     \
            R##_q0 = *(const uint4*)(QT + (seqrow + cc_ * 64 + srow0) * 512 + h * 128 + sc16 * 8); \
            R##_q1 = *(const uint4*)(QT + (seqrow + cc_ * 64 + srow1) * 512 + h * 128 + sc16 * 8); \
            R##_k0 = *(const uint4*)(KT + (seqrow + cc_ * 64 + srow0) * 512 + h * 128 + sc16 * 8); \
            R##_k1 = *(const uint4*)(KT + (seqrow + cc_ * 64 + srow1) * 512 + h * 128 + sc16 * 8); \
            const bf16_t* ktb_ = KTT + ((((size_t)(dir * NB + b) * NCHK + cc_) * 4 + h) * 128) * 64; \
            R##_kt0 = *(const uint4*)(ktb_ + (size_t)tid * 8); \
            R##_kt1 = *(const uint4*)(ktb_ + (size_t)(tid + 512) * 8); \
            { const int row_ = (tid & 255) >> 2, c4_ = tid & 3, s_ = min(cc_ * 64 + row_, LL - 1); const int l_ = dir ? (LL - 1 - s_) : s_; \
              R##_v = *(const uint4*)(proj + (size_t)(b * LL + l_) * PPAD + GV + h * 256 + slice * 32 + c4_ * 8); } \
            R##_eb = *(const f32x4_t*)(EBL + ((size_t)(dir * NB + b) * NCHK + cc_) * 512 + h * 128 + 16 * w + 4 * g); } while (0)
#define SC_STAGE(R, buf_, c_) do { unsigned char* bb_ = (buf_); \
            *(uint4*)(bb_ + OFF_Q + srow0 * QS + sc16 * 16) = R##_q0; \
            *(uint4*)(bb_ + OFF_Q + srow1 * QS + sc16 * 16) = R##_q1; \
            *(uint4*)(bb_ + OFF_K + srow0 * QS + sc16 * 16) = R##_k0; \
            *(uint4*)(bb_ + OFF_K + srow1 * QS + sc16 * 16) = R##_k1; \
            *(uint4*)(bb_ + OFF_KT + (tid >> 3) * TS + (tid & 7) * 16) = R##_kt0; \
            *(uint4*)(bb_ + OFF_KT + ((tid + 512) >> 3) * TS + (tid & 7) * 16) = R##_kt1; \
            if (tid < 256) { const int row_ = tid >> 2, c4_ = tid & 3; \
                if (min((c_), NCHK - 1) * 64 + row_ >= LL) R##_v = make_uint4(0u, 0u, 0u, 0u);     \
                bf16_t* vp_ = (bf16_t*)(bb_ + OFF_VT + (c4_ * 8) * TS) + row_; \
                vp_[0 * (TS / 2)] = (bf16_t)(R##_v.x & 0xffffu); vp_[1 * (TS / 2)] = (bf16_t)(R##_v.x >> 16); vp_[2 * (TS / 2)] = (bf16_t)(R##_v.y & 0xffffu); vp_[3 * (TS / 2)] = (bf16_t)(R##_v.y >> 16); \
                vp_[4 * (TS / 2)] = (bf16_t)(R##_v.z & 0xffffu); vp_[5 * (TS / 2)] = (bf16_t)(R##_v.z >> 16); vp_[6 * (TS / 2)] = (bf16_t)(R##_v.w & 0xffffu); vp_[7 * (TS / 2)] = (bf16_t)(R##_v.w >> 16); } } while (0)
        f32x4_t S[2]; S[0] = (f32x4_t){0.f, 0.f, 0.f, 0.f}; S[1] = S[0];
        f32x4_t ebc;
        auto step = [&](int c, const unsigned char* buf) {
            bf16x8_t fq[4], fk0[4], fk1[4], fkt[2], fv0[2], fv1[2], fst[4];
            const bool do0 = (2 * eo) <= tt, do1 = (2 * eo + 1) <= tt;
#pragma unroll
            for (int ks = 0; ks < 4; ++ks) { fq[ks] = *(const bf16x8_t*)(buf + OFF_Q + (16 * tt + fr) * QS + (32 * ks + 8 * g) * 2);
                fk0[ks] = *(const bf16x8_t*)(buf + OFF_K + (16 * (2 * eo) + fr) * QS + (32 * ks + 8 * g) * 2);
                fk1[ks] = *(const bf16x8_t*)(buf + OFF_K + (16 * (2 * eo + 1) + fr) * QS + (32 * ks + 8 * g) * 2);
                fst[ks] = *(const bf16x8_t*)(smem + OFF_ST + (16 * eo + fr) * QS + (32 * ks + 8 * g) * 2); }
#pragma unroll
            for (int ks = 0; ks < 2; ++ks) { fkt[ks] = *(const bf16x8_t*)(buf + OFF_KT + (16 * w + fr) * TS + (32 * ks + 8 * g) * 2);
                fv0[ks] = *(const bf16x8_t*)(buf + OFF_VT + (fr) * TS + (32 * ks + 8 * g) * 2);
                fv1[ks] = *(const bf16x8_t*)(buf + OFF_VT + (16 + fr) * TS + (32 * ks + 8 * g) * 2); }
            __builtin_amdgcn_sched_barrier(0);
            f32x4_t a0 = (f32x4_t){0.f, 0.f, 0.f, 0.f}, a1 = a0, O = a0; f32x4_t U[2]; U[0] = a0; U[1] = a0;
#pragma unroll
            for (int ks = 0; ks < 4; ++ks) {
                a0 = __builtin_amdgcn_mfma_f32_16x16x32_bf16(fk0[ks], fq[ks], a0, 0, 0, 0);
                a1 = __builtin_amdgcn_mfma_f32_16x16x32_bf16(fk1[ks], fq[ks], a1, 0, 0, 0);
                O = __builtin_amdgcn_mfma_f32_16x16x32_bf16(fst[ks], fq[ks], O, 0, 0, 0); }
#pragma unroll
            for (int ks = 0; ks < 2; ++ks) {
                U[0] = __builtin_amdgcn_mfma_f32_16x16x32_bf16(fkt[ks], fv0[ks], U[0], 0, 0, 0);
                U[1] = __builtin_amdgcn_mfma_f32_16x16x32_bf16(fkt[ks], fv1[ks], U[1], 0, 0, 0); }
            { const int t = 16 * tt + fr;
              if (do0) { const int u0 = 16 * (2 * eo) + 4 * g;
                  uint2 wv2; wv2.x = pk2(u0 + 0 <= t ? a0[0] : 0.f, u0 + 1 <= t ? a0[1] : 0.f); wv2.y = pk2(u0 + 2 <= t ? a0[2] : 0.f, u0 + 3 <= t ? a0[3] : 0.f);
                  *(uint2*)(smem + OFF_A + t * TS + u0 * 2) = wv2; }
              if (do1) { const int u0 = 16 * (2 * eo + 1) + 4 * g;
                  uint2 wv2; wv2.x = pk2(u0 + 0 <= t ? a1[0] : 0.f, u0 + 1 <= t ? a1[1] : 0.f); wv2.y = pk2(u0 + 2 <= t ? a1[2] : 0.f, u0 + 3 <= t ? a1[3] : 0.f);
                  *(uint2*)(smem + OFF_A + t * TS + u0 * 2) = wv2; } }
            __syncthreads();
            { bf16x8_t fa[2];
#pragma unroll
              for (int ks = 0; ks < 2; ++ks) fa[ks] = *(const bf16x8_t*)(smem + OFF_A + (16 * tt + fr) * TS + (32 * ks + 8 * g) * 2);
#pragma unroll
              for (int ks = 0; ks < 2; ++ks) O = __builtin_amdgcn_mfma_f32_16x16x32_bf16(eo ? fv1[ks] : fv0[ks], fa[ks], O, 0, 0, 0); }
            { const int s = c * 64 + 16 * tt + fr;
              if (s < LL) { const int l = dir ? (LL - 1 - s) : s;
                  uint2 ov; ov.x = pk2(O[0], O[1]); ov.y = pk2(O[2], O[3]);
                  *(uint2*)(outp + (size_t)(b * LL + l) * 1024 + h * 256 + slice * 32 + 16 * eo + 4 * g) = ov; } }
#pragma unroll
            for (int et = 0; et < 2; ++et) { S[et] = ebc * (S[et] + U[et]);
                uint2 sv; sv.x = pk2(S[et][0], S[et][1]); sv.y = pk2(S[et][2], S[et][3]);
                *(uint2*)(smem + OFF_ST + (16 * et + fr) * QS + (16 * w + 4 * g) * 2) = sv; }
        };
        SC_ISSUE(ra, 0); SC_STAGE(ra, smem, 0); ebc = ra_eb;
        SC_ISSUE(ra, 1);
        __syncthreads();
        for (int c = 0; c < NCHK + 1; c += 2) {
            SC_ISSUE(rb, c + 2);
            step(c, smem);
            SC_STAGE(ra, smem + BUFB, c + 1); ebc = ra_eb;
            __syncthreads();
            SC_ISSUE(ra, c + 3);
            step(c + 1, smem + BUFB);
            SC_STAGE(rb, smem, c + 2); ebc = rb_eb;
            __syncthreads();
        }
#undef SC_ISSUE
#undef SC_STAGE
    }
}

__device__ __forceinline__ void ph_na3(const Params& p, int layer, unsigned char* smem) {
    const bf16_t* proj = (const bf16_t*)(p.ws + WS_PROJ); const bf16_t* VT = (const bf16_t*)(p.ws + WS_VT);
    bf16_t* mix = (bf16_t*)(p.ws + WS_ACTB);
    const int tid = opaque_tid(), lane = tid & 63, wv = tid >> 6, fr = lane & 15, g = lane >> 4;
    float* bt = (float*)smem;
    constexpr int KS_OFF = 2048, VS_OFF = KS_OFF + 608 * 128, NA_LDS_END = VS_OFF + 76 * 1024;
    static_assert(NA_LDS_END <= LDS_BYTES - 16, "na lds");
    for (int it = xcd_vbid() * 8 + wv; it < 64; it += gridDim.x * 8) {
        const int h = it & 15, b = it >> 4, qrow = b * LL + fr;
        const bf16_t* qp = proj + (size_t)qrow * PPAD + NQ + h * 64 + 16 * g;
        const bf16x8_t q0 = *(const bf16x8_t*)(qp), q1 = *(const bf16x8_t*)(qp + 8);
        const int kkrow = 8 * (fr >> 2) + (fr & 3);
        f32x4_t sc2[2];
#pragma unroll
        for (int pz = 0; pz < 2; ++pz) { const bf16_t* kp = proj + (size_t)(b * LL + kkrow + 4 * pz) * PPAD + NK + h * 64 + 16 * g;
            f32x4_t acc = (f32x4_t){0.f, 0.f, 0.f, 0.f};
            acc = __builtin_amdgcn_mfma_f32_16x16x32_bf16(*(const bf16x8_t*)(kp), q0, acc, 0, 0, 0);
            acc = __builtin_amdgcn_mfma_f32_16x16x32_bf16(*(const bf16x8_t*)(kp + 8), q1, acc, 0, 0, 0);
            sc2[pz] = acc; }
        float mx = -1e30f;
#pragma unroll
        for (int pz = 0; pz < 2; ++pz)
#pragma unroll
            for (int j = 0; j < 4; ++j) { const float sv = (g < 2) ? sc2[pz][j] * 0.125f : -1e30f; sc2[pz][j] = sv; mx = fmaxf(mx, sv); }
        mx = fmaxf(mx, __shfl_xor(mx, 16)); mx = fmaxf(mx, __shfl_xor(mx, 32));
        float lsum = 0.f;
#pragma unroll
        for (int pz = 0; pz < 2; ++pz)
#pragma unroll
            for (int j = 0; j < 4; ++j) { const float pe = __expf(sc2[pz][j] - mx); sc2[pz][j] = pe; lsum += pe; }
        lsum += __shfl_xor(lsum, 16); lsum += __shfl_xor(lsum, 32);
        union { bf16x8_t v; unsigned u[4]; } pb;
        pb.u[0] = pk2(sc2[0][0], sc2[0][1]); pb.u[1] = pk2(sc2[0][2], sc2[0][3]); pb.u[2] = pk2(sc2[1][0], sc2[1][1]); pb.u[3] = pk2(sc2[1][2], sc2[1][3]);
        const bf16_t* vbase = VT + ((size_t)(b * 16 + h) * (LPAD / 8) + g) * 512 + fr * 8;
        const float inv = 1.f / lsum;
        bf16_t* op = mix + (size_t)qrow * DM + 1024 + h * 64 + 4 * g;
#pragma unroll
        for (int mt = 0; mt < 4; ++mt) { f32x4_t o = (f32x4_t){0.f, 0.f, 0.f, 0.f};
            o = __builtin_amdgcn_mfma_f32_16x16x32_bf16(*(const bf16x8_t*)(vbase + 128 * mt), pb.v, o, 0, 0, 0);
            uint2 wv2; wv2.x = pk2(o[0] * inv, o[1] * inv); wv2.y = pk2(o[2] * inv, o[3] * inv); *(uint2*)(op + 16 * mt) = wv2; }
    }
#define NA_F(l_) ((((l_) >> 1) & 1) | ((((l_) >> 3) & 3) << 1))
    for (int rnd = xcd_vbid(); rnd < 1024; rnd += gridDim.x) {
        const bool isgrid = true;
        const int b = rnd >> 8, h = (rnd >> 4) & 15, r0 = 2 * (rnd & 15), r = r0 + (wv >> 2), n = wv & 3;
        const int rsA = min(max(r0 - 4, 0), 24);
        __syncthreads();
        if (tid < 465) bt[tid] = p.relb[((size_t)layer * 16 + h) * 465 + tid];
        {
            typedef unsigned u32x4_t __attribute__((ext_vector_type(4)));
            u32x4_t kst[10], vst[10];
#pragma unroll
            for (int i = 0; i < 10; ++i) { const int idx = min(tid + 512 * i, 608 * 8 - 1), lrow = idx >> 3, ch = idx & 7;
                const int tok = lrow < 576 ? NMETA + min(rsA + (lrow >> 6), 31) * 64 + (lrow & 63) : lrow - 576;
                kst[i] = *(const u32x4_t*)(proj + (size_t)(b * LL + tok) * PPAD + NK + h * 64 + ch * 8); }
#pragma unroll
            for (int i = 0; i < 10; ++i) { const int idx = min(tid + 512 * i, 76 * 64 - 1), gi = idx >> 6, dh = idx & 63;
                const int tg = gi < 72 ? 2 + min(rsA + (gi >> 3), 31) * 8 + (gi & 7) : gi - 72;
                vst[i] = *(const u32x4_t*)(VT + (((size_t)(b * 16 + h) * (LPAD / 8) + tg) * 64 + dh) * 8); }
            __builtin_amdgcn_sched_barrier(0);
#pragma unroll
            for (int i = 0; i < 10; ++i) { const int idx = tid + 512 * i, lrow = idx >> 3, ch = idx & 7;
                if (idx < 608 * 8) *(u32x4_t*)(smem + KS_OFF + lrow * 128 + ((ch ^ NA_F(lrow)) * 16)) = kst[i]; }
#pragma unroll
            for (int i = 0; i < 10; ++i) { const int idx = tid + 512 * i, gi = idx >> 6, dh = idx & 63;
                if (idx < 76 * 64) *(u32x4_t*)(smem + VS_OFF + gi * 1024 + dh * 16) = vst[i]; }
        }
        __syncthreads();
        const int qrow = b * LL + NMETA + r * 64 + 16 * n + fr;
        const int rs = min(max(r - 4, 0), 24), cb = min(max(16 * n - 8, 0), 32);
        const bf16_t* qp = proj + (size_t)qrow * PPAD + NQ + h * 64 + 16 * g;
        const bf16x8_t q0 = *(const bf16x8_t*)(qp), q1 = *(const bf16x8_t*)(qp + 8);
        const int kkrow = 8 * (fr >> 2) + (fr & 3);
        f32x4_t sc[18];
#pragma unroll
        for (int kt = 0; kt < 18; ++kt) { const int kb = kt >> 1;
            const int lrow = (kb < 8 ? (rs - rsA + kb) * 64 + cb : 576) + kkrow + 4 * (kt & 1);
            const unsigned char* kp = smem + KS_OFF + lrow * 128; const int fl = NA_F(lrow);
            const bf16x8_t k0 = *(const bf16x8_t*)(kp + (((2 * g) ^ fl) * 16)), k1 = *(const bf16x8_t*)(kp + (((2 * g + 1) ^ fl) * 16));
            f32x4_t acc = (f32x4_t){0.f, 0.f, 0.f, 0.f};
            acc = __builtin_amdgcn_mfma_f32_16x16x32_bf16(k0, q0, acc, 0, 0, 0);
            acc = __builtin_amdgcn_mfma_f32_16x16x32_bf16(k1, q1, acc, 0, 0, 0);
            sc[kt] = acc; }
        const int qc = 16 * n + fr, cs = min(max(qc - 8, 0), 48);
        const float* bth = bt;
        float mx = -1e30f;
#pragma unroll
        for (int kt = 0; kt < 16; ++kt) { const int dr = rs + (kt >> 1) - r + 7;
#pragma unroll
            for (int j = 0; j < 4; ++j) { const int kc = cb + 8 * g + j + 4 * (kt & 1);
                const bool valid = isgrid && kc >= cs && kc < cs + 16;
                const int dc = min(max(kc - qc, -15), 15) + 15;
                const float sv = valid ? sc[kt][j] * 0.125f + bth[dr * 31 + dc] : -1e30f;
                sc[kt][j] = sv; mx = fmaxf(mx, sv); } }
#pragma unroll
        for (int kt = 16; kt < 18; ++kt)
#pragma unroll
            for (int j = 0; j < 4; ++j) { const float sv = (g < 2) ? sc[kt][j] * 0.125f : -1e30f;
                sc[kt][j] = sv; mx = fmaxf(mx, sv); }
        mx = fmaxf(mx, __shfl_xor(mx, 16)); mx = fmaxf(mx, __shfl_xor(mx, 32));
        float lsum = 0.f;
#pragma unroll
        for (int kt = 0; kt < 18; ++kt)
#pragma unroll
            for (int j = 0; j < 4; ++j) { const float pe = __expf(sc[kt][j] - mx); sc[kt][j] = pe; lsum += pe; }
        lsum += __shfl_xor(lsum, 16); lsum += __shfl_xor(lsum, 32);
        f32x4_t o[4];
#pragma unroll
        for (int mt = 0; mt < 4; ++mt) o[mt] = (f32x4_t){0.f, 0.f, 0.f, 0.f};
#pragma unroll
        for (int kb = 0; kb < 9; ++kb) {
            union { bf16x8_t v; unsigned u[4]; } pb;
            pb.u[0] = pk2(sc[2 * kb][0], sc[2 * kb][1]); pb.u[1] = pk2(sc[2 * kb][2], sc[2 * kb][3]);
            pb.u[2] = pk2(sc[2 * kb + 1][0], sc[2 * kb + 1][1]); pb.u[3] = pk2(sc[2 * kb + 1][2], sc[2 * kb + 1][3]);
            const unsigned char* vp = smem + VS_OFF + ((kb < 8 ? (rs - rsA + kb) * 8 + (cb >> 3) : 72) + g) * 1024 + fr * 16;
#pragma unroll
            for (int mt = 0; mt < 4; ++mt) o[mt] = __builtin_amdgcn_mfma_f32_16x16x32_bf16(*(const bf16x8_t*)(vp + 256 * mt), pb.v, o[mt], 0, 0, 0);
        }
        const float inv = 1.f / lsum;
        bf16_t* op = mix + (size_t)qrow * DM + 1024 + h * 64 + 4 * g;
#pragma unroll
        for (int mt = 0; mt < 4; ++mt) { uint2 wv2; wv2.x = pk2(o[mt][0] * inv, o[mt][1] * inv); wv2.y = pk2(o[mt][2] * inv, o[mt][3] * inv); *(uint2*)(op + 16 * mt) = wv2; }
    }
#undef NA_F
}

__device__ __forceinline__ void ph_ln(const Params& p, const float* w, const float* bvec, bool final_out, int nseg, unsigned char* smem) {
    bf16_t* hres = (bf16_t*)(p.ws + WS_HRES); const bf16_t* y = (const bf16_t*)(p.ws + WS_Y); const float* part = (const float*)(p.ws + WS_PART);
    const int tid_ = opaque_tid(), lane = tid_ & 63, wv = tid_ >> 6;
#define LN_FINISH(row_) { \
        float s = 0.f; \
        _Pragma("unroll") for (int j = 0; j < 4; ++j) { \
            v[2 * j] = DN_ALPHA * (f32x4_t){bf_lo(hr[j].x), bf_hi(hr[j].x), bf_lo(hr[j].y), bf_hi(hr[j].y)} + v[2 * j]; \
            v[2 * j + 1] = DN_ALPHA * (f32x4_t){bf_lo(hr[j].z), bf_hi(hr[j].z), bf_lo(hr[j].w), bf_hi(hr[j].w)} + v[2 * j + 1]; \
            s += (v[2 * j][0] + v[2 * j][1]) + (v[2 * j][2] + v[2 * j][3]) + (v[2 * j + 1][0] + v[2 * j + 1][1]) + (v[2 * j + 1][2] + v[2 * j + 1][3]); } \
        const float mean = wave_sum(s) * (1.f / DM); float s2 = 0.f; \
        _Pragma("unroll") for (int j = 0; j < 8; ++j) { v[j] = v[j] - mean; s2 += (v[j][0] * v[j][0] + v[j][1] * v[j][1]) + (v[j][2] * v[j][2] + v[j][3] * v[j][3]); } \
        const float rstd = 1.0f / sqrtf(wave_sum(s2) * (1.f / DM) + LN_EPS); \
        const int b_ = (row_) / LL, l_ = (row_) % LL; \
        if (!(final_out && l_ < NMETA)) { float* orow = p.out + ((size_t)b_ * TT + (l_ - NMETA)) * DM; \
            _Pragma("unroll") for (int j = 0; j < 4; ++j) { const int cc = j * 512 + lane * 8; \
                const f32x4_t o0 = v[2 * j] * rstd * lw[2 * j] + lb[2 * j]; \
                const f32x4_t o1 = v[2 * j + 1] * rstd * lw[2 * j + 1] + lb[2 * j + 1]; \
                if (final_out) { *(f32x4_t*)(orow + cc) = o0; *(f32x4_t*)(orow + cc + 4) = o1; } \
                else { uint4 pk; pk.x = pk2(o0[0], o0[1]); pk.y = pk2(o0[2], o0[3]); pk.z = pk2(o1[0], o1[1]); pk.w = pk2(o1[2], o1[3]); \
                    *(uint4*)(hres + (size_t)(row_) * DM + cc) = pk; } } } }
    {
        f32x4_t lw[8], lb[8];
#pragma unroll
        for (int j = 0; j < 4; ++j) { const int cc = j * 512 + lane * 8;
            lw[2 * j] = *(const f32x4_t*)(w + cc); lw[2 * j + 1] = *(const f32x4_t*)(w + cc + 4); lb[2 * j] = *(const f32x4_t*)(bvec + cc); lb[2 * j + 1] = *(const f32x4_t*)(bvec + cc + 4); }
        const int stride = gridDim.x * 8; int row = opaque_bid() * 8 + wv;
        uint4 hr[4], yr[4], hn[4], yn[4];
        if (row < 8192) {
#pragma unroll
            for (int j = 0; j < 4; ++j) { hr[j] = *(const uint4*)(hres + (size_t)row * DM + j * 512 + lane * 8); yr[j] = *(const uint4*)(y + (size_t)row * DM + j * 512 + lane * 8); }
        }
        for (; row < 8192; row += stride) {
            const int nrow = min(row + stride, 8191);
#pragma unroll
            for (int j = 0; j < 4; ++j) { hn[j] = *(const uint4*)(hres + (size_t)nrow * DM + j * 512 + lane * 8); yn[j] = *(const uint4*)(y + (size_t)nrow * DM + j * 512 + lane * 8); }
            __builtin_amdgcn_sched_barrier(0);
            f32x4_t v[8];
#pragma unroll
            for (int j = 0; j < 4; ++j) { v[2 * j] = (f32x4_t){bf_lo(yr[j].x), bf_hi(yr[j].x), bf_lo(yr[j].y), bf_hi(yr[j].y)}; v[2 * j + 1] = (f32x4_t){bf_lo(yr[j].z), bf_hi(yr[j].z), bf_lo(yr[j].w), bf_hi(yr[j].w)}; }
            LN_FINISH(row)
#pragma unroll
            for (int j = 0; j < 4; ++j) { hr[j] = hn[j]; yr[j] = yn[j]; }
        }
    }
    {
        float* red = (float*)smem;
        for (int rr = opaque_bid(); rr < 64; rr += gridDim.x) {
            const int row = 8192 + rr, col = wv * 256 + lane * 4;
            const uint2 hraw = *(const uint2*)(hres + (size_t)row * DM + col);
            f32x4_t yv = (f32x4_t){0.f, 0.f, 0.f, 0.f};
            for (int q = 0; q < nseg; q += 16) {
                f32x4_t pv[16];
#pragma unroll
                for (int qq = 0; qq < 16; ++qq) pv[qq] = *(const f32x4_t*)(part + ((size_t)(q + qq) * 64 + rr) * DM + col);
                __builtin_amdgcn_sched_barrier(0);
#pragma unroll
                for (int qq = 0; qq < 16; ++qq) yv += pv[qq]; }
            f32x4_t x = DN_ALPHA * (f32x4_t){bf_lo(hraw.x), bf_hi(hraw.x), bf_lo(hraw.y), bf_hi(hraw.y)} + yv;
            const float s = wave_sum((x[0] + x[1]) + (x[2] + x[3]));
            __syncthreads();
            if (lane == 0) red[wv] = s;
            __syncthreads();
            float tot = 0.f;
#pragma unroll
            for (int i = 0; i < 8; ++i) tot += red[i];
            const float mean = tot * (1.f / DM);
            x = x - mean;
            const float s2 = wave_sum((x[0] * x[0] + x[1] * x[1]) + (x[2] * x[2] + x[3] * x[3]));
            if (lane == 0) red[8 + wv] = s2;
            __syncthreads();
            float tot2 = 0.f;
#pragma unroll
            for (int i = 0; i < 8; ++i) tot2 += red[8 + i];
            const float rstd = 1.0f / sqrtf(tot2 * (1.f / DM) + LN_EPS);
            const f32x4_t o = x * rstd * *(const f32x4_t*)(w + col) + *(const f32x4_t*)(bvec + col);
            const int b_ = row / LL, l_ = row % LL;
            if (final_out) *(f32x4_t*)(p.out + ((size_t)b_ * TT + (l_ - NMETA)) * DM + col) = o;
            else { uint2 pk; pk.x = pk2(o[0], o[1]); pk.y = pk2(o[2], o[3]); *(uint2*)(hres + (size_t)row * DM + col) = pk; }
        }
    }
#undef LN_FINISH
}

struct SplitOrder {
    pg8::StaticOrder so; int nfull, nseg, segk, nN, nMfull, G, c;
    __device__ void init(int nMfull_, int N, int K, int nsegk, int G_, int c_) { nMfull = nMfull_; nN = N / 256; G = G_; c = c_; so.init(nMfull_ * 256, N, G_, c_); so.ntile = K / 64; nfull = nMfull_ * nN;
        segk = nsegk > 0 ? (K / 64) / nsegk : 0; nseg = nsegk * nN; }
    __device__ bool next(int i, pg8::Unit& u) const {
        const int L = i * G + c;
        if (L < nfull) return so.next(i, u);
        const int j = L - nfull; if (j >= nseg) return false;
        u.pm = nMfull; u.pn = j % nN; u.k0 = (j / nN) * segk; u.nt = segk; u.kind = 1; return true;
    }
    __device__ __forceinline__ void a_ready(const pg8::Unit&) const {}
    __device__ __forceinline__ void done(const pg8::Unit&) const {}
};
template <class Epi> __device__ __forceinline__ void ph_gemm(unsigned char* smem, const bf16_t* A, const bf16_t* Bt, int M, int N, int K, int nsegk, const Epi& E, int nMfull = -1) {
    asm volatile("" : "+s"(M), "+s"(N), "+s"(K), "+s"(nsegk));
    pg8::Gemm g; g.A = A; g.Bt = Bt; g.M = M; g.N = N; g.K = K;
    if (nMfull < 0) nMfull = nsegk > 0 ? M / 256 - 1 : M / 256;
    SplitOrder S; S.init(nMfull, N, K, nsegk, (int)gridDim.x, opaque_bid());
    pg8::gemm_phase<Epi, SplitOrder, true, true>((PG8_LAS unsigned char*)smem, g, S, E);
}

#ifndef MK_REP_MASK
#define MK_REP_MASK 0
#endif
template <int ACT> __device__ __forceinline__ void skinny_task(const bf16_t* A, const bf16_t* Bt, int K, int row0, int col0, bf16_t* O, int ldc, int tid, unsigned char* smem) {
    const int lane = tid & 63, w = tid >> 6, fr = lane & 15, g = lane >> 4;
    asm volatile("" : "+s"(K) :: "memory");
    const int kw = K >> 3;
    const bf16_t* ap = A + (size_t)(row0 + fr) * K + w * kw + 8 * g;
    const bf16_t* bp = Bt + (size_t)(col0 + fr) * K + w * kw + 8 * g;
    f32x4_t acc[4][2];
#pragma unroll
    for (int rt = 0; rt < 4; ++rt) { acc[rt][0] = (f32x4_t){0.f, 0.f, 0.f, 0.f}; acc[rt][1] = acc[rt][0]; }
    for (int k0 = 0; k0 < kw; k0 += 128) {
        bf16x8_t a[4][4], bb[2][4];
#pragma unroll
        for (int i = 0; i < 4; ++i) {
#pragma unroll
            for (int rt = 0; rt < 4; ++rt) a[rt][i] = *(const bf16x8_t*)(ap + (size_t)(16 * rt) * K + k0 + 32 * i);
#pragma unroll
            for (int ct = 0; ct < 2; ++ct) bb[ct][i] = *(const bf16x8_t*)(bp + (size_t)(16 * ct) * K + k0 + 32 * i); }
        __builtin_amdgcn_sched_barrier(0);
#pragma unroll
        for (int i = 0; i < 4; ++i)
#pragma unroll
            for (int rt = 0; rt < 4; ++rt)
#pragma unroll
                for (int ct = 0; ct < 2; ++ct) acc[rt][ct] = __builtin_amdgcn_mfma_f32_16x16x32_bf16(bb[ct][i], a[rt][i], acc[rt][ct], 0, 0, 0);
    }
    f32x4_t* red = (f32x4_t*)smem;
#pragma unroll
    for (int rt = 0; rt < 4; ++rt)
#pragma unroll
        for (int ct = 0; ct < 2; ++ct) red[(w * 8 + rt * 2 + ct) * 64 + lane] = acc[rt][ct];
    __syncthreads();
    f32x4_t r = red[(0 * 8 + w) * 64 + lane];
#pragma unroll
    for (int q = 1; q < 8; ++q) r += red[(q * 8 + w) * 64 + lane];
    if (ACT == 1) {
#pragma unroll
        for (int j = 0; j < 4; ++j) { const float x = fmaxf(r[j], 0.f); r[j] = x * x; } }
    const int rt = w >> 1, ct = w & 1;
    uint2 o; o.x = pk2(r[0], r[1]); o.y = pk2(r[2], r[3]);
    *(uint2*)(O + (size_t)(row0 + 16 * rt + fr) * ldc + col0 + 16 * ct + 4 * g) = o;
    __syncthreads();
}

#ifndef MK_REP_MASK
#define MK_REP_MASK 0
#endif
constexpr int PH_PER_LAYER = 9, NPH = 1 + NLAYER * PH_PER_LAYER;

__device__ __forceinline__ void run_phase(const Params& p, int ph, unsigned char* smem) {
    if (ph == 0) { ph_prologue(p, smem); return; }
    const int layer = (ph - 1) / PH_PER_LAYER, s = (ph - 1) % PH_PER_LAYER;
    unsigned char* ws = p.ws;
    switch (s) {
    case 0: { pg8::EpiBf16<0> E; E.O = (bf16_t*)(ws + WS_PROJ); E.ldc = PPAD;
              const bf16_t* A = (const bf16_t*)(ws + WS_HRES); const bf16_t* Bt = (const bf16_t*)(ws + WS_WT_IN + layer * SZ_WT_IN);
              ph_gemm(smem, A, Bt, MPAD, 6144, DM, 0, E, 32);
              const int tid = opaque_tid();
              for (int t = opaque_bid(); t < 193 + 128; t += gridDim.x) {
                  if (t < 193) skinny_task<0>(A, Bt, DM, 8192, 32 * t, (bf16_t*)(ws + WS_PROJ), PPAD, tid, smem);
                  else skinny_task<0>(A, Bt, DM, 64 * (t - 193), 6144, (bf16_t*)(ws + WS_PROJ), PPAD, tid, smem); } } break;
    case 1: ph_gla_prep(p, layer, smem);
#if MK_REP_MASK & (1 << 22)
            ph_gla_prep(p, layer, smem);
#endif
            ph_vt(p, smem);
#if MK_REP_MASK & (1 << 23)
            ph_vt(p, smem);
#endif
            break;
    case 2: ph_gla_scan2(p, layer, smem); break;
    case 3: ph_na3(p, layer, smem);
#if MK_REP_MASK & (1 << 20)
            ph_na3(p, layer, smem);
#endif
            ph_gla_combine(p, layer);
#if MK_REP_MASK & (1 << 21)
            ph_gla_combine(p, layer);
#endif
            break;
    case 4: { pg8::EpiY E; E.Y = (bf16_t*)(ws + WS_Y); E.ldc = DM; E.part = (float*)(ws + WS_PART);
              ph_gemm(smem, (const bf16_t*)(ws + WS_ACTB), (const bf16_t*)(ws + WS_WT_OUT + layer * SZ_WT_OUT), MPAD, DM, DM, NSEG_OUT, E); } break;
    case 5: ph_ln(p, p.ln1w + layer * DM, p.ln1b + layer * DM, false, NSEG_OUT, smem); break;
    case 6: { pg8::EpiBf16<1> E; E.O = (bf16_t*)(ws + WS_HID); E.ldc = DFF;
              const bf16_t* A = (const bf16_t*)(ws + WS_HRES); const bf16_t* Bt = (const bf16_t*)(ws + WS_WT_FF1 + layer * SZ_WT_FF);
              ph_gemm(smem, A, Bt, MPAD, DFF, DM, 0, E, 32);
              const int tid = opaque_tid();
              for (int t = opaque_bid(); t < 256; t += gridDim.x) skinny_task<1>(A, Bt, DM, 8192, 32 * t, (bf16_t*)(ws + WS_HID), DFF, tid, smem); } break;
    case 7: { pg8::EpiY E; E.Y = (bf16_t*)(ws + WS_Y); E.ldc = DM; E.part = (float*)(ws + WS_PART);
              ph_gemm(smem, (const bf16_t*)(ws + WS_HID), (const bf16_t*)(ws + WS_WT_FF2 + layer * SZ_WT_FF), MPAD, DM, DFF, NSEG_FF2, E); } break;
    default: ph_ln(p, p.ln2w + layer * DM, p.ln2b + layer * DM, layer == NLAYER - 1, NSEG_FF2, smem); break;
    }
}

__global__ __launch_bounds__(512, 2) void mega_fwd(Params p) {
    extern __shared__ __attribute__((aligned(16))) unsigned char smem[];
    volatile LAS unsigned* xst = (volatile LAS unsigned*)(LAS unsigned char*)(smem + LDS_BYTES - 16);
    XcdBarrier xb;
    if (p.coop) {
        if (threadIdx.x == 0) { xst[0] = 0u; xst[1] = 0u; }
        __syncthreads();
        xb = xcd_barrier_post((unsigned*)(p.ws + WS_BAR), xst);
    }
#if MK_REP_MASK & (1 << 17)
    if (p.coop) for (int i = 0; i < 20; ++i) xcd_barrier(xb);
#endif
    for (int ph = p.ph_lo; ph < p.ph_hi; ++ph) {
        if (ph > p.ph_lo && p.coop) {
            if (p.pad != 0) cg::this_grid().sync();
            xcd_barrier(xb);
        }
        run_phase(p, ph, smem);
#if MK_REP_MASK
        if (ph > 0 ? ((MK_REP_MASK >> ((ph - 1) % PH_PER_LAYER)) & 1) : ((MK_REP_MASK >> 16) & 1)) { if (p.coop) xcd_barrier(xb); run_phase(p, ph, smem); }
#endif
    }
}

#ifndef MK_ONE_LAUNCH
#define MK_ONE_LAUNCH 0
#endif

extern "C" void kernel_launch(void* const* d_in, const int* in_sizes, int n_in, void* d_out, int out_size, void* d_ws, size_t ws_size, hipStream_t stream) {
    static int grid = 0;
    if (grid == 0) {
        if (n_in != 14 || in_sizes[0] != NB * TT * DM || out_size != NB * TT * DM || ws_size < WS_TOTAL) {
            fprintf(stderr, "kernel_launch: unexpected shapes or workspace (%zu < %zu); nothing launched\n", ws_size, (size_t)WS_TOTAL); grid = -1; return; }
        int dev = 0, cus = 0, per_cu = 0;
        hipGetDevice(&dev); hipDeviceGetAttribute(&cus, hipDeviceAttributeMultiprocessorCount, dev);
        if (hipFuncSetAttribute((const void*)mega_fwd, hipFuncAttributeMaxDynamicSharedMemorySize, LDS_BYTES) != hipSuccess) { fprintf(stderr, "kernel_launch: hipFuncSetAttribute failed\n"); grid = -1; return; }
        if (hipOccupancyMaxActiveBlocksPerMultiprocessor(&per_cu, (const void*)mega_fwd, 512, LDS_BYTES) != hipSuccess || per_cu < 1) { fprintf(stderr, "kernel_launch: occupancy query failed (%d)\n", per_cu); (void)hipGetLastError(); per_cu = 1; }
        grid = cus * per_cu;
    }
    if (grid < 0) return;
#if MK_ONE_LAUNCH
    if (hipMemsetAsync((char*)d_ws + WS_BAR, 0, (size_t)XCD_BAR_WORDS * 4, stream) != hipSuccess) { fprintf(stderr, "kernel_launch: memset of the barrier words failed\n"); return; }
#endif
    Params p{};
    p.x = (const float*)d_in[0]; p.meta = (const float*)d_in[1]; p.w_in = (const float*)d_in[2]; p.w_up = (const float*)d_in[3]; p.b_up = (const float*)d_in[4];
    p.gnorm = (const float*)d_in[5]; p.relb = (const float*)d_in[6]; p.w_out = (const float*)d_in[7]; p.ln1w = (const float*)d_in[8]; p.ln1b = (const float*)d_in[9];
    p.w_ff1 = (const float*)d_in[10]; p.w_ff2 = (const float*)d_in[11]; p.ln2w = (const float*)d_in[12]; p.ln2b = (const float*)d_in[13];
    p.out = (float*)d_out; p.ws = (unsigned char*)d_ws;
#if MK_ONE_LAUNCH
    p.ph_lo = 0; p.ph_hi = NPH; p.coop = 1;
    void* args[] = {&p};
    hipError_t e = hipLaunchCooperativeKernel((const void*)mega_fwd, dim3(grid), dim3(512), args, LDS_BYTES, stream);
    if (e != hipSuccess) fprintf(stderr, "cooperative launch failed: %s (grid %d)\n", hipGetErrorString(e), grid);
#else
    for (int ph = 0; ph < NPH; ++ph) {
        p.ph_lo = ph; p.ph_hi = ph + 1; p.coop = 0;
        hipLaunchKernelGGL(mega_fwd, dim3(grid), dim3(512), LDS_BYTES, stream, p);
    }
#endif
}
```

```cpp
#include <hip/hip_runtime.h>
#include <hip/hip_cooperative_groups.h>
#include <cstdio>
#include <cstdint>
namespace cg = cooperative_groups;
#define MK_ONE_LAUNCH 1
#define MK_REP_MASK 0
namespace pg8 {
#define PG8_LAS __attribute__((address_space(3)))
typedef unsigned short bf16_t;
typedef short bf16x8 __attribute__((ext_vector_type(8)));
typedef float f32x4 __attribute__((ext_vector_type(4)));
typedef unsigned u32x4 __attribute__((ext_vector_type(4)));
constexpr int BM = 256, BK = 64, HALF = 128, HTB = HALF * BK * 2  , STAGE_BYTES = 8 * HTB, NXCD = 8, WGM = 2;

__host__ __device__ __forceinline__ int lds_byte(int r, int c) { const int st = (r >> 4) * 2 + (c >> 5), rr = r & 15, cc = c & 31, ob = rr * 64 + cc * 2; return st * 1024 + (ob ^ (((ob >> 9) & 1) << 5)); }
__host__ __device__ __forceinline__ void stage_rc(int b, int& R, int& C) { const int st = b / 1024, sb = b % 1024, swz = sb ^ (((sb >> 9) & 1) << 5); R = (st >> 1) * 16 + swz / 64; C = (st & 1) * 32 + (swz % 64) / 2; }
__host__ __device__ __forceinline__ int perm32(int rho) { const int n = rho >> 4, i = rho & 15; return 8 * (i >> 2) + 4 * n + (i & 3); }

struct Unit { int pm, pn, k0, nt, kind; };
struct Gemm { const bf16_t* A; const bf16_t* Bt; int M, N, K; };

struct StaticOrder {
    int nM, nN, nwg, G, c, ntile;
    __host__ __device__ void init(int M, int N, int G_, int c_) { nM = M / BM; nN = N / BM; nwg = nM * nN; G = G_; c = c_; }
    __host__ __device__ bool next(int i, Unit& u) const {
        const long L = (long)i * G + c; if (L >= nwg) return false;
        int wgid = (int)L; { const int q = nwg / NXCD, r = nwg % NXCD, xcd = wgid % NXCD, off = wgid / NXCD; wgid = (xcd < r ? xcd * (q + 1) : r * (q + 1) + (xcd - r) * q) + off; }
        const int nig = WGM * nN, gid = wgid / nig, fm = gid * WGM, gsz = (nM - fm) < WGM ? (nM - fm) : WGM;
        u.pm = fm + ((wgid % nig) % gsz); u.pn = (wgid % nig) / gsz; u.k0 = 0; u.nt = ntile; u.kind = 0; return true;
    }
    __device__ __forceinline__ void a_ready(const Unit&) const {}
    __device__ __forceinline__ void done(const Unit&) const {}
};
__device__ __forceinline__ unsigned cvt_pk_bf16(float lo, float hi) { unsigned r; asm volatile("v_cvt_pk_bf16_f32 %0, %1, %2" : "=v"(r) : "v"(lo), "v"(hi)); return r; }
typedef float f32x2 __attribute__((ext_vector_type(2)));
struct EpiY {
    static constexpr bool PERM = true, AFTER_DRAIN = false;
    bf16_t* Y; int ldc; float* part;
    __device__ __forceinline__ void operator()(const f32x4 (&acc)[2][2][4][2], const Unit& u, int wr, int wc, int fr, int fq) const {
        const int col0 = u.pn * BM + wc * 32 + 8 * fq;
        if (u.kind == 0) {
            const int row0 = u.pm * BM + wr * 64 + fr;
#pragma unroll
            for (int ai = 0; ai < 2; ++ai)
#pragma unroll
                for (int m = 0; m < 4; ++m) { bf16_t* rowp = Y + (size_t)(row0 + ai * HALF + m * 16) * ldc + col0;
#pragma unroll
                    for (int bj = 0; bj < 2; ++bj) { const f32x4 v0 = acc[ai][bj][m][0], v1 = acc[ai][bj][m][1];
                        u32x4 w; w.x = cvt_pk_bf16(v0[0], v0[1]); w.y = cvt_pk_bf16(v0[2], v0[3]); w.z = cvt_pk_bf16(v1[0], v1[1]); w.w = cvt_pk_bf16(v1[2], v1[3]);
                        *(u32x4*)(rowp + bj * HALF) = w; } }
        } else if (wr == 0) {
            float* pb = part + (size_t)(u.k0 / u.nt) * 64 * ldc;
#pragma unroll
            for (int m = 0; m < 4; ++m) { float* rowp = pb + (size_t)(m * 16 + fr) * ldc + col0;
#pragma unroll
                for (int bj = 0; bj < 2; ++bj)
#pragma unroll
                    for (int n = 0; n < 2; ++n) *(f32x4*)(rowp + bj * HALF + n * 4) = acc[0][bj][m][n]; }
        }
    }
};
template <int ACT  > struct EpiBf16 {
    static constexpr bool PERM = true, AFTER_DRAIN = false;
    bf16_t* O; int ldc;
    __device__ __forceinline__ void operator()(const f32x4 (&acc)[2][2][4][2], const Unit& u, int wr, int wc, int fr, int fq) const {
        const int row0 = u.pm * BM + wr * 64 + fr; const int col0 = u.pn * BM + wc * 32 + 8 * fq;
#pragma unroll
        for (int ai = 0; ai < 2; ++ai)
#pragma unroll
            for (int m = 0; m < 4; ++m) { bf16_t* rowp = O + (size_t)(row0 + ai * HALF + m * 16) * ldc + col0;
#pragma unroll
                for (int bj = 0; bj < 2; ++bj) { f32x4 v0 = acc[ai][bj][m][0], v1 = acc[ai][bj][m][1];
                    if (ACT == 1) {
#pragma unroll
                        for (int j = 0; j < 4; ++j) { const float a = fmaxf(v0[j], 0.f), b = fmaxf(v1[j], 0.f); v0[j] = a * a; v1[j] = b * b; } }
                    u32x4 w; w.x = cvt_pk_bf16(v0[0], v0[1]); w.y = cvt_pk_bf16(v0[2], v0[3]); w.z = cvt_pk_bf16(v1[0], v1[1]); w.w = cvt_pk_bf16(v1[2], v1[3]);
                    *(u32x4*)(rowp + bj * HALF) = w; } }
    }
};
template <class Epi, class Sched, bool ALIGN_EPI = false, bool SP2 = false>
__device__ __forceinline__ void gemm_phase(PG8_LAS unsigned char* lds, const Gemm g, const Sched& S, const Epi& E) {
    int tid = threadIdx.x; asm volatile("" : "+v"(tid));
    const int wid = __builtin_amdgcn_readfirstlane(tid >> 6), lane = tid & 63, wr = wid >> 2, wc = wid & 3, fr = lane & 15, fq = lane >> 4;
    const int K = g.K;
    unsigned voffA[2], voffB[2];
#pragma unroll
    for (int i = 0; i < 2; ++i) { int R, C; stage_rc(tid * 16 + i * 8192, R, C); const int Rb = Epi::PERM ? ((R & ~31) + perm32(R & 31)) : R;
        voffA[i] = (unsigned)(R * K + C) * 2u; voffB[i] = (unsigned)(Rb * K + C) * 2u; }
    const size_t kstep = (size_t)(BK * 2);
    const size_t hstep = (size_t)HALF * K * 2;
    const size_t tstep = 2 * hstep;
    const unsigned ldsw = (unsigned)wid * 1024u;
    const int aoff = lds_byte(wr * 64 + fr, fq * 8), boff = lds_byte(wc * 32 + fr, fq * 8);
#define PG8_SA(b, h) (((b) * 2 + (h)) * HTB)
#define PG8_SB(b, h) ((4 + (b) * 2 + (h)) * HTB)
#define PG8_STAGE(bufoff, gbase, voff) do { _Pragma("unroll") for (int _i = 0; _i < 2; ++_i) \
        __builtin_amdgcn_global_load_lds((const unsigned*)((const char*)(gbase) + (voff)[_i]), (PG8_LAS unsigned*)(lds + (bufoff) + ldsw + _i * 8192), 16, 0, 0); } while (0)
#define PG8_LDA(dst, b, h) do { _Pragma("unroll") for (int m = 0; m < 4; ++m) _Pragma("unroll") for (int k = 0; k < 2; ++k) dst[m][k] = *(const PG8_LAS bf16x8*)(lds + PG8_SA(b, h) + aoff + m * 2048 + k * 1024); } while (0)
#define PG8_LDB(dst, b, h) do { _Pragma("unroll") for (int n = 0; n < 2; ++n) _Pragma("unroll") for (int k = 0; k < 2; ++k) dst[n][k] = *(const PG8_LAS bf16x8*)(lds + PG8_SB(b, h) + boff + n * 2048 + k * 1024); } while (0)
#define PG8_MMA(ai, bj, At, Bt) do { __builtin_amdgcn_s_setprio(1); _Pragma("unroll") for (int m = 0; m < 4; ++m) _Pragma("unroll") for (int n = 0; n < 2; ++n) _Pragma("unroll") for (int k = 0; k < 2; ++k) \
        acc[ai][bj][m][n] = __builtin_amdgcn_mfma_f32_16x16x32_bf16(Bt[n][k], At[m][k], acc[ai][bj][m][n], 0, 0, 0); __builtin_amdgcn_s_setprio(0); } while (0)
#define PG8_WAIT_V(n) asm volatile("s_waitcnt vmcnt(" #n ")" ::: "memory")
#define PG8_WAIT_L(n) asm volatile("s_waitcnt lgkmcnt(" #n ")" ::: "memory")
#define PG8_BAR __builtin_amdgcn_s_barrier()
#define PG8_SCHED __builtin_amdgcn_sched_barrier(0)
    Unit cur, nxt; int ui = 0;
    if (!S.next(0, cur)) return;
    f32x4 acc[2][2][4][2];
#pragma unroll
    for (int a = 0; a < 2; ++a)
#pragma unroll
        for (int b = 0; b < 2; ++b)
#pragma unroll
            for (int m = 0; m < 4; ++m)
#pragma unroll
                for (int n = 0; n < 2; ++n) acc[a][b][m][n] = (f32x4){0.f, 0.f, 0.f, 0.f};
    bf16x8 At[4][2], B0[2][2], B1[2][2];
    const char* cA = (const char*)g.A + (size_t)cur.pm * tstep + (size_t)cur.k0 * kstep; const char* cB = (const char*)g.Bt + (size_t)cur.pn * tstep + (size_t)cur.k0 * kstep;
    S.a_ready(cur);
    if constexpr (SP2) {
        PG8_STAGE(PG8_SB(0, 0), cB, voffB); PG8_STAGE(PG8_SB(0, 1), cB + hstep, voffB); PG8_STAGE(PG8_SA(0, 0), cA, voffA); PG8_STAGE(PG8_SA(0, 1), cA + hstep, voffA);
        if (wr == 1) PG8_BAR;
        PG8_WAIT_V(2); PG8_BAR;
        PG8_STAGE(PG8_SB(1, 0), cB + kstep, voffB); PG8_STAGE(PG8_SA(1, 0), cA + kstep, voffA); PG8_STAGE(PG8_SB(1, 1), cB + hstep + kstep, voffB);
        PG8_WAIT_V(6); PG8_BAR;
    } else {
        PG8_STAGE(PG8_SB(0, 0), cB, voffB); PG8_STAGE(PG8_SA(0, 0), cA, voffA); PG8_STAGE(PG8_SB(0, 1), cB + hstep, voffB); PG8_STAGE(PG8_SA(0, 1), cA + hstep, voffA);
        if (wr == 1) PG8_BAR;
        PG8_WAIT_V(4); PG8_BAR;
        PG8_STAGE(PG8_SB(1, 0), cB + kstep, voffB); PG8_STAGE(PG8_SA(1, 0), cA + kstep, voffA); PG8_STAGE(PG8_SB(1, 1), cB + hstep + kstep, voffB);
        PG8_WAIT_V(6); PG8_BAR;
    }
    for (;;) {
        const bool has_next = S.next(ui + 1, nxt);
        const char* nA = has_next ? (const char*)g.A + (size_t)nxt.pm * tstep + (size_t)nxt.k0 * kstep : cA; const char* nB = has_next ? (const char*)g.Bt + (size_t)nxt.pn * tstep + (size_t)nxt.k0 * kstep : cB;
        const int nt = cur.nt;
        for (int t = 0; t < nt; t += 2) {
            const bool last = (t == nt - 2);
            const char* a1 = cA + (size_t)(t + 1) * kstep;
            const char* a2 = last ? nA : cA + (size_t)(t + 2) * kstep; const char* b2 = last ? nB : cB + (size_t)(t + 2) * kstep;
            const char* a3 = a2 + kstep; const char* b3 = b2 + kstep;
            if (last && has_next) S.a_ready(nxt);
            if constexpr (SP2) {
            PG8_LDB(B0, 0, 0); PG8_LDB(B1, 0, 1); PG8_SCHED; PG8_LDA(At, 0, 0); PG8_STAGE(PG8_SA(1, 1), a1 + hstep, voffA);
            PG8_WAIT_V(8); PG8_WAIT_L(0); PG8_BAR; PG8_MMA(0, 0, At, B0); PG8_MMA(0, 1, At, B1); PG8_BAR; PG8_SCHED;
            PG8_LDA(At, 0, 1); PG8_STAGE(PG8_SB(0, 0), b2, voffB); PG8_STAGE(PG8_SB(0, 1), b2 + hstep, voffB); PG8_STAGE(PG8_SA(0, 0), a2, voffA);
            PG8_WAIT_V(8); PG8_WAIT_L(0); PG8_BAR; PG8_MMA(1, 0, At, B0); PG8_MMA(1, 1, At, B1); PG8_BAR; PG8_SCHED;
            PG8_LDB(B0, 1, 0); PG8_LDB(B1, 1, 1); PG8_SCHED; PG8_LDA(At, 1, 0); PG8_STAGE(PG8_SA(0, 1), a2 + hstep, voffA);
            PG8_WAIT_V(8); PG8_WAIT_L(0); PG8_BAR; PG8_MMA(0, 0, At, B0); PG8_MMA(0, 1, At, B1); PG8_BAR; PG8_SCHED;
            PG8_LDA(At, 1, 1); PG8_STAGE(PG8_SB(1, 0), b3, voffB); PG8_STAGE(PG8_SB(1, 1), b3 + hstep, voffB); PG8_STAGE(PG8_SA(1, 0), a3, voffA);
            PG8_WAIT_V(8); PG8_WAIT_L(0); PG8_BAR; PG8_MMA(1, 0, At, B0); PG8_MMA(1, 1, At, B1); PG8_BAR; PG8_SCHED;
            } else {
            PG8_LDB(B0, 0, 0); PG8_SCHED; PG8_LDA(At, 0, 0); PG8_STAGE(PG8_SA(1, 1), a1 + hstep, voffA);
            PG8_WAIT_L(8); PG8_BAR; PG8_WAIT_L(0); PG8_MMA(0, 0, At, B0); PG8_BAR; PG8_SCHED;
            PG8_LDB(B1, 0, 1); PG8_STAGE(PG8_SB(0, 0), b2, voffB);
            PG8_BAR; PG8_WAIT_L(0); PG8_MMA(0, 1, At, B1); PG8_BAR;
            PG8_LDA(At, 0, 1); PG8_STAGE(PG8_SA(0, 0), a2, voffA);
            PG8_BAR; PG8_WAIT_L(0); PG8_MMA(1, 0, At, B0); PG8_BAR; PG8_SCHED;
            PG8_STAGE(PG8_SB(0, 1), b2 + hstep, voffB);
            PG8_WAIT_V(6); PG8_BAR; PG8_MMA(1, 1, At, B1); PG8_BAR;
            PG8_LDB(B0, 1, 0); PG8_SCHED; PG8_LDA(At, 1, 0); PG8_STAGE(PG8_SA(0, 1), a2 + hstep, voffA);
            PG8_WAIT_L(8); PG8_BAR; PG8_WAIT_L(0); PG8_MMA(0, 0, At, B0); PG8_BAR; PG8_SCHED;
            PG8_LDB(B1, 1, 1); PG8_STAGE(PG8_SB(1, 0), b3, voffB);
            PG8_BAR; PG8_WAIT_L(0); PG8_MMA(0, 1, At, B1); PG8_BAR;
            PG8_LDA(At, 1, 1); PG8_STAGE(PG8_SA(1, 0), a3, voffA);
            PG8_BAR; PG8_WAIT_L(0); PG8_MMA(1, 0, At, B0); PG8_BAR; PG8_SCHED;
            PG8_STAGE(PG8_SB(1, 1), b3 + hstep, voffB);
            PG8_WAIT_V(6); PG8_BAR; PG8_MMA(1, 1, At, B1); PG8_BAR;
            }
        }
        if constexpr (ALIGN_EPI) { if (wr == 0) PG8_BAR; }
        if constexpr (!Epi::AFTER_DRAIN) { E(acc, cur, wr, wc, fr, fq); S.done(cur); }
        if (!has_next) break;
#pragma unroll
        for (int a = 0; a < 2; ++a)
#pragma unroll
            for (int b = 0; b < 2; ++b)
#pragma unroll
                for (int m = 0; m < 4; ++m)
#pragma unroll
                    for (int n = 0; n < 2; ++n) acc[a][b][m][n] = (f32x4){0.f, 0.f, 0.f, 0.f};
        cur = nxt; cA = nA; cB = nB; ++ui;
        if constexpr (ALIGN_EPI) { if (wr == 1) PG8_BAR; }
    }
    PG8_WAIT_V(0);
    if constexpr (!ALIGN_EPI) { if (wr == 0) PG8_BAR; }
    PG8_BAR;
    if constexpr (Epi::AFTER_DRAIN) { E.fused(acc, cur, wr, wc, fr, fq, lds, wid, lane); S.done(cur); }
#undef PG8_SA
#undef PG8_SB
#undef PG8_STAGE
#undef PG8_LDA
#undef PG8_LDB
#undef PG8_MMA
#undef PG8_WAIT_V
#undef PG8_WAIT_L
#undef PG8_BAR
#undef PG8_SCHED
}
}
#define LAS __attribute__((address_space(3)))
#define XB_TMO      128
#define XB_XCNT(j)  (256  + 64 * (j))
#define XB_XSUB(j)  (1280 + 64 * (j))
#define XB_XGEN(j)  (2304 + 64 * (j))
#define XB_TOP      3328
#define XB_TOPGEN   3392
#define XCD_BAR_WORDS 3456
#define XB_SPIN_CAP (1u << 18)

__device__ __forceinline__ unsigned xb_ld(unsigned* p)              { return __hip_atomic_load(p, __ATOMIC_RELAXED, __HIP_MEMORY_SCOPE_AGENT); }
__device__ __forceinline__ unsigned xb_add(unsigned* p, unsigned v) { return __hip_atomic_fetch_add(p, v, __ATOMIC_RELAXED, __HIP_MEMORY_SCOPE_AGENT); }
__device__ __forceinline__ unsigned xb_xcc_id() { return (unsigned)__builtin_amdgcn_s_getreg((3 << 11) | 20) & 0xFu; }
#define XB_SPIN(cond, bar) do { unsigned _sp = 0; while (cond) { __builtin_amdgcn_s_sleep(0); \
    if ((++_sp & 255u) == 0u) { if (xb_ld(&(bar)[XB_TMO])) break; if (_sp > XB_SPIN_CAP) { atomicAdd(&(bar)[XB_TMO], 1u); break; } } } } while (0)

struct XcdBarrier {
    unsigned* bar; unsigned x;
    volatile LAS unsigned* st;
};

__device__ __forceinline__ XcdBarrier xcd_barrier_post(unsigned* bar, volatile LAS unsigned* st) {
    XcdBarrier b; b.bar = bar; b.x = xb_xcc_id(); b.st = st;
    if (threadIdx.x == 0) (void)xb_add(&bar[XB_XCNT(b.x)], 1u);
    return b;
}
__device__ __forceinline__ void xcd_barrier_complete(unsigned* bar, unsigned x, unsigned& nloc, unsigned& nx) {
    const unsigned G = gridDim.x * gridDim.y * gridDim.z;
    unsigned sum, cnt, mine, sp = 0u;
    for (;;) {
        sum = 0u; cnt = 0u; mine = 0u;
#pragma unroll
        for (unsigned j = 0; j < 16; ++j) { const unsigned c = xb_ld(&bar[XB_XCNT(j)]); sum += c; cnt += (c > 0u) ? 1u : 0u; mine = (j == x) ? c : mine; }
        if (sum == G) break;
        __builtin_amdgcn_s_sleep(1);
        if ((++sp & 255u) == 0u) { if (xb_ld(&bar[XB_TMO])) break; if (sp > XB_SPIN_CAP) { atomicAdd(&bar[XB_TMO], 1u); break; } }
    }
    nloc = mine > 0u ? mine : 1u; nx = cnt > 0u ? cnt : 1u;
}

__device__ __forceinline__ void xcd_barrier(const XcdBarrier& b) {
    asm volatile("s_waitcnt vmcnt(0)" ::: "memory");
    __syncthreads();
    if (threadIdx.x == 0) {
        unsigned* bar = b.bar;
        __builtin_amdgcn_s_waitcnt(0);
        unsigned nloc = b.st[0], nx = b.st[1];
        if (nloc == 0u) { xcd_barrier_complete(bar, b.x, nloc, nx); b.st[0] = nloc; b.st[1] = nx; }
        const unsigned old = xb_add(&bar[XB_XSUB(b.x)], 1u);
        const unsigned gen = old / nloc;
        if (old + 1u == (gen + 1u) * nloc) {
            __builtin_amdgcn_fence(__ATOMIC_RELEASE, "agent");
            asm volatile("s_waitcnt vmcnt(0)" ::: "memory");
            const unsigned og = xb_add(&bar[XB_TOP], 1u);
            const unsigned tg = og / nx;
            if (og + 1u == (tg + 1u) * nx) xb_add(&bar[XB_TOPGEN], 1u);
            else XB_SPIN(xb_ld(&bar[XB_TOPGEN]) == tg, bar);
            __builtin_amdgcn_fence(__ATOMIC_ACQUIRE, "agent");
            xb_add(&bar[XB_XGEN(b.x)], 1u);
            asm volatile("s_waitcnt vmcnt(0)" ::: "memory");
        } else {
            XB_SPIN(xb_ld(&bar[XB_XGEN(b.x)]) == gen, bar);
            __builtin_amdgcn_fence(__ATOMIC_ACQUIRE, "agent");
            asm volatile("s_waitcnt vmcnt(0)" ::: "memory");
        }
    }
    __syncthreads();
}


typedef unsigned short bf16_t;
typedef float f32x4_t __attribute__((ext_vector_type(4)));


constexpr int NB = 4, TT = 2048, NMETA = 16, LL = 2064, DM = 2048, MTOK = NB * LL  , MPAD = 8448, PP = 6176, PPAD = 6400, DFF = 8192;
constexpr int GQ = 0, GK = 512, GV = 1024, GR = 2048, NQ = 3072, NK = 4096, NV = 5120, LR = 6144;
constexpr int NLAYER = 2;
constexpr int LDS_BYTES = 163840;
constexpr float DN_ALPHA = 1.41421356237f;
constexpr float LN_EPS = 1e-5f;

constexpr size_t SZ_WT_IN = (size_t)PPAD * DM * 2, SZ_WT_OUT = (size_t)DM * DM * 2, SZ_WT_FF = (size_t)DFF * DM * 2;
constexpr size_t WS_WT_IN = 0, WS_WT_OUT = WS_WT_IN + NLAYER * SZ_WT_IN, WS_WT_FF1 = WS_WT_OUT + NLAYER * SZ_WT_OUT, WS_WT_FF2 = WS_WT_FF1 + NLAYER * SZ_WT_FF;
constexpr size_t WS_HRES = WS_WT_FF2 + NLAYER * SZ_WT_FF;
constexpr size_t WS_ACTB = WS_HRES + (size_t)MPAD * DM * 4;
constexpr size_t WS_R = WS_ACTB + (size_t)MPAD * DM * 2;
constexpr size_t WS_PROJ = WS_R;
constexpr int LPAD = 2112, NCHK = 33;
constexpr size_t SZ_QT = (size_t)2 * NB * LPAD * 512 * 2;
constexpr size_t WS_QT = WS_HRES + (size_t)MPAD * DM * 2, WS_KT = WS_QT + SZ_QT;
static_assert(2 * SZ_QT <= (size_t)MPAD * DM * 2, "qt/kt overlay");
constexpr size_t WS_KTT = WS_PROJ + (size_t)MPAD * PPAD * 2;
constexpr size_t WS_EBL = WS_KTT + SZ_QT;
constexpr size_t WS_VT = WS_EBL + (size_t)2 * NB * NCHK * 512 * 4;
constexpr size_t WS_OF = WS_VT + (size_t)NB * 16 * 64 * LPAD * 2;
constexpr size_t WS_OB = WS_OF + (size_t)MTOK * 1024 * 4;
constexpr size_t WS_HID = WS_R;
constexpr size_t WS_Y = WS_HID + (size_t)MPAD * DFF * 2;
constexpr size_t WS_END0 = WS_Y + (size_t)MPAD * DM * 4, WS_END1 = WS_OB + (size_t)MTOK * 1024 * 4;
constexpr size_t WS_END = WS_END0 > WS_END1 ? WS_END0 : WS_END1;
constexpr int NSEG_OUT = 16, NSEG_FF2 = 32;
constexpr size_t WS_PART = WS_END0;
constexpr size_t WS_END2 = WS_PART + (size_t)NSEG_FF2 * 64 * DM * 4;
constexpr size_t WS_BAR = ((WS_END > WS_END2 ? WS_END : WS_END2) + 255) / 256 * 256;
constexpr size_t WS_TOTAL = WS_BAR + (size_t)XCD_BAR_WORDS * 4;
static_assert(WS_TOTAL <= (size_t)536870912, "workspace budget");

struct Params {
    const float *x, *meta, *w_in, *w_up, *b_up, *gnorm, *relb, *w_out, *ln1w, *ln1b, *w_ff1, *w_ff2, *ln2w, *ln2b;
    float* out;
    unsigned char* ws;
    int ph_lo, ph_hi, coop, pad;
};

__device__ __forceinline__ int opaque_tid() { int t = threadIdx.x; asm volatile("" : "+v"(t)); return t; }
__device__ __forceinline__ int opaque_bid() { int t = blockIdx.x; asm volatile("" : "+s"(t)); return t; }
__device__ __forceinline__ int xcd_vbid() { const int b = opaque_bid(), G = (int)gridDim.x; return (G & 7) ? b : (b & 7) * (G >> 3) + (b >> 3); }
__device__ __forceinline__ float bf_lo(unsigned u) { return __uint_as_float(u << 16); }
__device__ __forceinline__ float bf_hi(unsigned u) { return __uint_as_float(u & 0xffff0000u); }
__device__ __forceinline__ float bf1(bf16_t u) { return __uint_as_float(((unsigned)u) << 16); }
__device__ __forceinline__ unsigned pk2(float lo, float hi) { return pg8::cvt_pk_bf16(lo, hi); }
__device__ __forceinline__ float wave_sum(float v) {
#pragma unroll
    for (int o = 1; o < 64; o <<= 1) v += __shfl_xor(v, o);
    return v;
}

__device__ __forceinline__ void ph_prologue(const Params& p, unsigned char* smem) {
    float* tile = (float*)smem;
    constexpr int I_IN = (PPAD / 256) * (DM / 64), I_OUT = (DM / 256) * (DM / 64), I_FF1 = (DFF / 256) * (DM / 64), I_FF2 = (DM / 256) * (DFF / 64);
    constexpr int I_LAYER = I_IN + I_OUT + I_FF1 + I_FF2, I_TOT = NLAYER * I_LAYER;
    {
        const int t = opaque_tid(), n = t & 255, kk = t >> 8, kc = t & 7, nb = t >> 3, G = gridDim.x;
        const float* w = nullptr; bf16_t* wT = nullptr; int N = 0, K = 0, k0 = 0, n0 = 0, mode = 0;
        auto decode = [&](int it) {
            const int layer = it / I_LAYER; int r = it % I_LAYER;
            if (r < I_IN) { const int nt = PPAD / 256; w = p.w_in + (size_t)layer * DM * PP; N = PP; K = DM; k0 = (r / nt) * 64; n0 = (r % nt) * 256; wT = (bf16_t*)(p.ws + WS_WT_IN + layer * SZ_WT_IN); mode = 1; return; }
            r -= I_IN;
            if (r < I_OUT) { const int nt = DM / 256; w = p.w_out + (size_t)layer * DM * DM; N = DM; K = DM; k0 = (r / nt) * 64; n0 = (r % nt) * 256; wT = (bf16_t*)(p.ws + WS_WT_OUT + layer * SZ_WT_OUT); mode = 0; return; }
            r -= I_OUT;
            if (r < I_FF1) { const int nt = DFF / 256; w = p.w_ff1 + (size_t)layer * DM * DFF; N = DFF; K = DM; k0 = (r / nt) * 64; n0 = (r % nt) * 256; wT = (bf16_t*)(p.ws + WS_WT_FF1 + layer * SZ_WT_FF); mode = 0; return; }
            r -= I_FF1;
            { const int nt = DM / 256; w = p.w_ff2 + (size_t)layer * DFF * DM; N = DM; K = DFF; k0 = (r / nt) * 64; n0 = (r % nt) * 256; wT = (bf16_t*)(p.ws + WS_WT_FF2 + layer * SZ_WT_FF); mode = 0; }
        };
        float v[32];
#define CV_LOAD() { const int jn = n0 + n; int src = jn; if (mode == 1) src = jn < 3072 ? jn : (jn < 6144 ? jn + 32 : (jn < 6176 ? jn - 3072 : -1)); \
            _Pragma("unroll") for (int i = 0; i < 32; ++i) v[i] = src >= 0 ? __builtin_nontemporal_load(&w[(size_t)(k0 + kk + 2 * i) * N + src]) : 0.f; }
        int it = opaque_bid();
        if (it < I_TOT) { decode(it); CV_LOAD() }
        while (it < I_TOT) {
#pragma unroll
            for (int i = 0; i < 32; ++i) tile[(kk + 2 * i) * 257 + n] = v[i];
            __syncthreads();
            bf16_t* cwT = wT; const int cK = K, ck0 = k0, cn0 = n0;
            const int itn = it + G;
            if (itn < I_TOT) { decode(itn); CV_LOAD() }
#pragma unroll
            for (int i = 0; i < 4; ++i) { const int nn = nb + 64 * i; const float* tp = tile + (kc * 8) * 257 + nn;
                uint4 o; o.x = pk2(tp[0], tp[257]); o.y = pk2(tp[2 * 257], tp[3 * 257]); o.z = pk2(tp[4 * 257], tp[5 * 257]); o.w = pk2(tp[6 * 257], tp[7 * 257]);
                *(uint4*)(cwT + (size_t)(cn0 + nn) * cK + ck0 + kc * 8) = o; }
            __syncthreads();
            it = itn;
        }
#undef CV_LOAD
    }
    bf16_t* hres = (bf16_t*)(p.ws + WS_HRES); bf16_t* actb = (bf16_t*)(p.ws + WS_ACTB);
    const int c4 = opaque_tid() * 4;
    for (int row = opaque_bid(); row < MPAD; row += gridDim.x) {
        f32x4_t v = (f32x4_t){0.f, 0.f, 0.f, 0.f};
        if (row < MTOK) { const int b = row / LL, l = row % LL;
            const float* src = l < NMETA ? p.meta + (size_t)l * DM : p.x + ((size_t)b * TT + (l - NMETA)) * DM;
            v = *(const f32x4_t*)(src + c4); }
        uint2 o; o.x = pk2(v[0], v[1]); o.y = pk2(v[2], v[3]);
        *(uint2*)(hres + (size_t)row * DM + c4) = o;
    }
}

__device__ __forceinline__ void ph_gla_combine(const Params& p, int layer) {
    const bf16_t* proj = (const bf16_t*)(p.ws + WS_PROJ);
    const bf16_t* of = (const bf16_t*)(p.ws + WS_OF); const bf16_t* ob = (const bf16_t*)(p.ws + WS_OB);
    bf16_t* mix = (bf16_t*)(p.ws + WS_ACTB);
    const float* gn = p.gnorm + layer * 256;
    const int tid_ = opaque_tid(), lane = tid_ & 63, wv = tid_ >> 6;
    const f32x4_t g4 = *(const f32x4_t*)(gn + lane * 4);
    for (int row = opaque_bid() * 8 + wv; row < MTOK; row += gridDim.x * 8) {
        uint2 a[4], bb[4]; uint2 rr[4];
#pragma unroll
        for (int h = 0; h < 4; ++h) { a[h] = *(const uint2*)(of + (size_t)row * 1024 + h * 256 + lane * 4); bb[h] = *(const uint2*)(ob + (size_t)row * 1024 + h * 256 + lane * 4);
            rr[h] = *(const uint2*)(proj + (size_t)row * PPAD + GR + h * 256 + lane * 4); }
        __builtin_amdgcn_sched_barrier(0);
#pragma unroll
        for (int h = 0; h < 4; ++h) {
            const f32x4_t o = (f32x4_t){bf_lo(a[h].x) + bf_lo(bb[h].x), bf_hi(a[h].x) + bf_hi(bb[h].x), bf_lo(a[h].y) + bf_lo(bb[h].y), bf_hi(a[h].y) + bf_hi(bb[h].y)};
            const float ss = wave_sum(o[0] * o[0] + o[1] * o[1] + o[2] * o[2] + o[3] * o[3]);
            const float rstd = 1.0f / sqrtf(ss * (1.f / 256.f) + LN_EPS);
            const float r0 = bf_lo(rr[h].x), r1 = bf_hi(rr[h].x), r2 = bf_lo(rr[h].y), r3 = bf_hi(rr[h].y);
            const float y0 = o[0] * rstd * g4[0] * (r0 / (1.f + __expf(-r0))), y1 = o[1] * rstd * g4[1] * (r1 / (1.f + __expf(-r1)));
            const float y2 = o[2] * rstd * g4[2] * (r2 / (1.f + __expf(-r2))), y3 = o[3] * rstd * g4[3] * (r3 / (1.f + __expf(-r3)));
            uint2 w; w.x = pk2(y0, y1); w.y = pk2(y2, y3);
            *(uint2*)(mix + (size_t)row * DM + h * 256 + lane * 4) = w;
        }
    }
}

typedef short bf16x8_t __attribute__((ext_vector_type(8)));
__device__ __forceinline__ bf16_t f2bf(float x) { return (bf16_t)(pk2(x, 0.f) & 0xffffu); }
__device__ __forceinline__ void ph_gla_prep(const Params& p, int layer, unsigned char* smem) {
    const bf16_t* proj = (const bf16_t*)(p.ws + WS_PROJ);
    bf16_t* QT = (bf16_t*)(p.ws + WS_QT); bf16_t* KT = (bf16_t*)(p.ws + WS_KT); bf16_t* KTT = (bf16_t*)(p.ws + WS_KTT); float* EBL = (float*)(p.ws + WS_EBL);
    const float* w_up = p.w_up + (size_t)layer * 2 * 16 * 512; const float* b_up = p.b_up + (size_t)layer * 2 * 512;
    const int tid = opaque_tid(), d = tid & 127, tq = tid >> 7;
    float* lr_s = (float*)smem; float* part = lr_s + 1024;
    for (int item = opaque_bid(); item < 2 * NB * NCHK * 4; item += gridDim.x) {
        const int h = item & 3; int r_ = item >> 2; const int c = r_ % NCHK; r_ /= NCHK; const int b = r_ & 3, dir = r_ >> 2;
        __syncthreads();
        { const int t = tid >> 3, rr = (tid & 7) * 2; const int s = c * 64 + t; const bool val = s < LL; const int l = val ? (dir ? (LL - 1 - s) : s) : 0;
          const unsigned u = *(const unsigned*)(proj + (size_t)(b * LL + l) * PPAD + LR + dir * 16 + rr);
          lr_s[t * 16 + rr] = bf_lo(u); lr_s[t * 16 + rr + 1] = bf_hi(u); }
        bf16_t qraw[16], kraw[16];
#pragma unroll
        for (int i = 0; i < 16; ++i) { const int s = c * 64 + tq * 16 + i; const bool val = s < LL; const int l = val ? (dir ? (LL - 1 - s) : s) : 0;
            const bf16_t* rp = proj + (size_t)(b * LL + l) * PPAD; qraw[i] = rp[GQ + h * 128 + d]; kraw[i] = rp[GK + h * 128 + d]; }
        float wup[16];
#pragma unroll
        for (int r = 0; r < 16; ++r) wup[r] = w_up[(size_t)(dir * 16 + r) * 512 + h * 128 + d];
        const float bu = b_up[dir * 512 + h * 128 + d];
        __syncthreads();
        float g[16]; float run = 0.f;
#pragma unroll
        for (int i = 0; i < 16; ++i) { const int t = tq * 16 + i, s = c * 64 + t;
            float z = bu;
#pragma unroll
            for (int r4 = 0; r4 < 4; ++r4) { const f32x4_t v = *(const f32x4_t*)(lr_s + t * 16 + r4 * 4);
                z += v[0] * wup[r4 * 4 + 0] + v[1] * wup[r4 * 4 + 1] + v[2] * wup[r4 * 4 + 2] + v[3] * wup[r4 * 4 + 3]; }
            const float ls = fminf(z, 0.f) - __logf(1.f + __expf(-fabsf(z)));
            run += (s < LL) ? ls * 0.0625f : 0.f; g[i] = run; }
        part[tq * 128 + d] = run;
        __syncthreads();
        float off = 0.f, tot = 0.f;
#pragma unroll
        for (int q = 0; q < 4; ++q) { const float pv = part[q * 128 + d]; off += (q < tq) ? pv : 0.f; tot += pv; }
        const size_t seqrow = (size_t)(dir * NB + b) * LPAD;
        unsigned kt_pk[8];
#pragma unroll
        for (int i = 0; i < 16; ++i) { const int t = tq * 16 + i, s = c * 64 + t; const bool val = s < LL; const int l = val ? (dir ? (LL - 1 - s) : s) : 0;
            const float qv = val ? bf1(qraw[i]) : 0.f, kv = val ? bf1(kraw[i]) : 0.f;
            const float bc = off + g[i];
            const float qd = qv * 0.08838834764831845f * __expf(bc), kd = kv * __expf(-bc);
            QT[(seqrow + s) * 512 + h * 128 + d] = f2bf(qd);
            const bf16_t kb = f2bf(kd);
            KT[(seqrow + s) * 512 + h * 128 + d] = kb;
            if (i & 1) kt_pk[i >> 1] |= ((unsigned)kb) << 16; else kt_pk[i >> 1] = kb; }
        { bf16_t* kp = KTT + ((((size_t)(dir * NB + b) * NCHK + c) * 4 + h) * 128 + d) * 64 + tq * 16;
          *(uint4*)(kp) = make_uint4(kt_pk[0], kt_pk[1], kt_pk[2], kt_pk[3]); *(uint4*)(kp + 8) = make_uint4(kt_pk[4], kt_pk[5], kt_pk[6], kt_pk[7]); }
        if (tq == 0) EBL[((size_t)(dir * NB + b) * NCHK + c) * 512 + h * 128 + d] = __expf(tot);
    }
}

__device__ __forceinline__ void ph_vt(const Params& p, unsigned char* smem) {
    const bf16_t* proj = (const bf16_t*)(p.ws + WS_PROJ); bf16_t* VT = (bf16_t*)(p.ws + WS_VT);
    const int tid = opaque_tid();
    bf16_t* T = (bf16_t*)smem;
    typedef unsigned u32x4_t __attribute__((ext_vector_type(4)));
    constexpr int NIT = NB * 16 * NCHK;
    for (int base = opaque_bid() * 4; base < NIT; base += gridDim.x * 4) {
        u32x4_t u[4];
#pragma unroll
        for (int i = 0; i < 4; ++i) { const int item = min(base + i, NIT - 1), tb = item % NCHK, bh = item / NCHK, h = bh & 15, b = bh >> 4;
            const int tok = tid >> 3, c = tid & 7, l = min(tb * 64 + tok, LL - 1);
            u[i] = *(const u32x4_t*)(proj + (size_t)(b * LL + l) * PPAD + NV + h * 64 + c * 8); }
        __builtin_amdgcn_sched_barrier(0);
        __syncthreads();
#pragma unroll
        for (int i = 0; i < 4; ++i) { const int item = min(base + i, NIT - 1), tb = item % NCHK;
            const int tok = tid >> 3, c = tid & 7;
            const u32x4_t v = (tb * 64 + tok < LL) ? u[i] : (u32x4_t){0u, 0u, 0u, 0u};
            bf16_t* tp = T + i * (64 * 72) + (c * 8) * 72 + tok;
            tp[0 * 72] = (bf16_t)(v.x & 0xffffu); tp[1 * 72] = (bf16_t)(v.x >> 16); tp[2 * 72] = (bf16_t)(v.y & 0xffffu); tp[3 * 72] = (bf16_t)(v.y >> 16);
            tp[4 * 72] = (bf16_t)(v.z & 0xffffu); tp[5 * 72] = (bf16_t)(v.z >> 16); tp[6 * 72] = (bf16_t)(v.w & 0xffffu); tp[7 * 72] = (bf16_t)(v.w >> 16); }
        __syncthreads();
#pragma unroll
        for (int i = 0; i < 4; ++i) { const int item = base + i;
            if (item < NIT) { const int tb = item % NCHK, bh = item / NCHK, h = bh & 15, b = bh >> 4;
                const int dh = tid & 63, c = tid >> 6;
                *(uint4*)(VT + (((size_t)(b * 16 + h) * (LPAD / 8) + tb * 8 + c) * 64 + dh) * 8) = *(const uint4*)(T + i * (64 * 72) + dh * 72 + c * 8); } }
    }
}

__device__ __forceinline__ void ph_gla_scan2(const Params& p, int layer, unsigned char* smem) {
    const bf16_t* proj = (const bf16_t*)(p.ws + WS_PROJ);
    const bf16_t* QT = (const bf16_t*)(p.ws + WS_QT); const bf16_t* KT = (const bf16_t*)(p.ws + WS_KT); const bf16_t* KTT = (const bf16_t*)(p.ws + WS_KTT); const float* EBL = (const float*)(p.ws + WS_EBL);
    const int tid = opaque_tid(), lane = tid & 63, w = tid >> 6, fr = lane & 15, g = lane >> 4;
    constexpr int QS = 272, TS = 144;
    constexpr int OFF_Q = 0, OFF_K = 64 * QS, OFF_KT = 2 * 64 * QS, OFF_VT = OFF_KT + 128 * TS, BUFB = OFF_VT + 32 * TS;
    constexpr int OFF_A = 2 * BUFB, OFF_ST = OFF_A + 64 * TS, LDS_END = OFF_ST + 32 * QS;
    static_assert(LDS_END <= LDS_BYTES, "lds");
    const int tt = w >> 1, eo = w & 1;
    for (int item = xcd_vbid(); item < 256; item += gridDim.x) {
        const int slice = item & 7, seq = item >> 3, dir = seq & 1, h = (seq >> 1) & 3, b = seq >> 3;
        bf16_t* outp = (bf16_t*)(p.ws + (dir ? WS_OB : WS_OF));
        const size_t seqrow = (size_t)(dir * NB + b) * LPAD;
        __syncthreads();
        for (int i = tid; i < (64 * TS + 32 * QS) / 4; i += 512) ((unsigned*)(smem + OFF_A))[i] = 0u;
        uint4 ra_q0, ra_q1, ra_k0, ra_k1, ra_kt0, ra_kt1, ra_v, rb_q0, rb_q1, rb_k0, rb_k1, rb_kt0, rb_kt1, rb_v; f32x4_t ra_eb, rb_eb;
        const int srow0 = tid >> 4, srow1 = (tid + 512) >> 4, sc16 = tid & 15;
#define SC_ISSUE(R, c_) do { const int cc_ = min((c_), NCHK - 1);     \
            R##_q0 = *(const uint4*)(QT + (seqrow + cc_ * 64 + srow0) * 512 + h * 128 + sc16 * 8); \
            R##_q1 = *(const uint4*)(QT + (seqrow + cc_ * 64 + srow1) * 512 + h * 128 + sc16 * 8); \
            R##_k0 = *(const uint4*)(KT + (seqrow + cc_ * 64 + srow0) * 512 + h * 128 + sc16 * 8); \
            R##_k1 = *(const uint4*)(KT + (seqrow + cc_ * 64 + srow1) * 512 + h * 128 + sc16 * 8); \
            const bf16_t* ktb_ = KTT + ((((size_t)(dir * NB + b) * NCHK + cc_) * 4 + h) * 128) * 64; \
            R##_kt0 = *(const uint4*)(ktb_ + (size_t)tid * 8); \
            R##_kt1 = *(const uint4*)(ktb_ + (size_t)(tid + 512) * 8); \
            { const int row_ = (tid & 255) >> 2, c4_ = tid & 3, s_ = min(cc_ * 64 + row_, LL - 1); const int l_ = dir ? (LL - 1 - s_) : s_; \
              R##_v = *(const uint4*)(proj + (size_t)(b * LL + l_) * PPAD + GV + h * 256 + slice * 32 + c4_ * 8); } \
            R##_eb = *(const f32x4_t*)(EBL + ((size_t)(dir * NB + b) * NCHK + cc_) * 512 + h * 128 + 16 * w + 4 * g); } while (0)
#define SC_STAGE(R, buf_, c_) do { unsigned char* bb_ = (buf_); \
            *(uint4*)(bb_ + OFF_Q + srow0 * QS + sc16 * 16) = R##_q0; \
            *(uint4*)(bb_ + OFF_Q + srow1 * QS + sc16 * 16) = R##_q1; \
            *(uint4*)(bb_ + OFF_K + srow0 * QS + sc16 * 16) = R##_k0; \
            *(uint4*)(bb_ + OFF_K + srow1 * QS + sc16 * 16) = R##_k1; \
            *(uint4*)(bb_ + OFF_KT + (tid >> 3) * TS + (tid & 7) * 16) = R##_kt0; \
            *(uint4*)(bb_ + OFF_KT + ((tid + 512) >> 3) * TS + (tid & 7) * 16) = R##_kt1; \
            if (tid < 256) { const int row_ = tid >> 2, c4_ = tid & 3; \
                if (min((c_), NCHK - 1) * 64 + row_ >= LL) R##_v = make_uint4(0u, 0u, 0u, 0u);     \
                bf16_t* vp_ = (bf16_t*)(bb_ + OFF_VT + (c4_ * 8) * TS) + row_; \
                vp_[0 * (TS / 2)] = (bf16_t)(R##_v.x & 0xffffu); vp_[1 * (TS / 2)] = (bf16_t)(R##_v.x >> 16); vp_[2 * (TS / 2)] = (bf16_t)(R##_v.y & 0xffffu); vp_[3 * (TS / 2)] = (bf16_t)(R##_v.y >> 16); \
                vp_[4 * (TS / 2)] = (bf16_t)(R##_v.z & 0xffffu); vp_[5 * (TS / 2)] = (bf16_t)(R##_v.z >> 16); vp_[6 * (TS / 2)] = (bf16_t)(R##_v.w & 0xffffu); vp_[7 * (TS / 2)] = (bf16_t)(R##_v.w >> 16); } } while (0)
        f32x4_t S[2]; S[0] = (f32x4_t){0.f, 0.f, 0.f, 0.f}; S[1] = S[0];
        f32x4_t ebc;
        auto step = [&](int c, const unsigned char* buf) {
            bf16x8_t fq[4], fk0[4], fk1[4], fkt[2], fv0[2], fv1[2], fst[4];
            const bool do0 = (2 * eo) <= tt, do1 = (2 * eo + 1) <= tt;
#pragma unroll
            for (int ks = 0; ks < 4; ++ks) { fq[ks] = *(const bf16x8_t*)(buf + OFF_Q + (16 * tt + fr) * QS + (32 * ks + 8 * g) * 2);
                fk0[ks] = *(const bf16x8_t*)(buf + OFF_K + (16 * (2 * eo) + fr) * QS + (32 * ks + 8 * g) * 2);
                fk1[ks] = *(const bf16x8_t*)(buf + OFF_K + (16 * (2 * eo + 1) + fr) * QS + (32 * ks + 8 * g) * 2);
                fst[ks] = *(const bf16x8_t*)(smem + OFF_ST + (16 * eo + fr) * QS + (32 * ks + 8 * g) * 2); }
#pragma unroll
            for (int ks = 0; ks < 2; ++ks) { fkt[ks] = *(const bf16x8_t*)(buf + OFF_KT + (16 * w + fr) * TS + (32 * ks + 8 * g) * 2);
                fv0[ks] = *(const bf16x8_t*)(buf + OFF_VT + (fr) * TS + (32 * ks + 8 * g) * 2);
                fv1[ks] = *(const bf16x8_t*)(buf + OFF_VT + (16 + fr) * TS + (32 * ks + 8 * g) * 2); }
            __builtin_amdgcn_sched_barrier(0);
            f32x4_t a0 = (f32x4_t){0.f, 0.f, 0.f, 0.f}, a1 = a0, O = a0; f32x4_t U[2]; U[0] = a0; U[1] = a0;
#pragma unroll
            for (int ks = 0; ks < 4; ++ks) {
                a0 = __builtin_amdgcn_mfma_f32_16x16x32_bf16(fk0[ks], fq[ks], a0, 0, 0, 0);
                a1 = __builtin_amdgcn_mfma_f32_16x16x32_bf16(fk1[ks], fq[ks], a1, 0, 0, 0);
                O = __builtin_amdgcn_mfma_f32_16x16x32_bf16(fst[ks], fq[ks], O, 0, 0, 0); }
#pragma unroll
            for (int ks = 0; ks < 2; ++ks) {
                U[0] = __builtin_amdgcn_mfma_f32_16x16x32_bf16(fkt[ks], fv0[ks], U[0], 0, 0, 0);
                U[1] = __builtin_amdgcn_mfma_f32_16x16x32_bf16(fkt[ks], fv1[ks], U[1], 0, 0, 0); }
            { const int t = 16 * tt + fr;
              if (do0) { const int u0 = 16 * (2 * eo) + 4 * g;
                  uint2 wv2; wv2.x = pk2(u0 + 0 <= t ? a0[0] : 0.f, u0 + 1 <= t ? a0[1] : 0.f); wv2.y = pk2(u0 + 2 <= t ? a0[2] : 0.f, u0 + 3 <= t ? a0[3] : 0.f);
                  *(uint2*)(smem + OFF_A + t * TS + u0 * 2) = wv2; }
              if (do1) { const int u0 = 16 * (2 * eo + 1) + 4 * g;
                  uint2 wv2; wv2.x = pk2(u0 + 0 <= t ? a1[0] : 0.f, u0 + 1 <= t ? a1[1] : 0.f); wv2.y = pk2(u0 + 2 <= t ? a1[2] : 0.f, u0 + 3 <= t ? a1[3] : 0.f);
                  *(uint2*)(smem + OFF_A + t * TS + u0 * 2) = wv2; } }
            __syncthreads();
            { bf16x8_t fa[2];
#pragma unroll
              for (int ks = 0; ks < 2; ++ks) fa[ks] = *(const bf16x8_t*)(smem + OFF_A + (16 * tt + fr) * TS + (32 * ks + 8 * g) * 2);
#pragma unroll
              for (int ks = 0; ks < 2; ++ks) O = __builtin_amdgcn_mfma_f32_16x16x32_bf16(eo ? fv1[ks] : fv0[ks], fa[ks], O, 0, 0, 0); }
            { const int s = c * 64 + 16 * tt + fr;
              if (s < LL) { const int l = dir ? (LL - 1 - s) : s;
                  uint2 ov; ov.x = pk2(O[0], O[1]); ov.y = pk2(O[2], O[3]);
                  *(uint2*)(outp + (size_t)(b * LL + l) * 1024 + h * 256 + slice * 32 + 16 * eo + 4 * g) = ov; } }
#pragma unroll
            for (int et = 0; et < 2; ++et) { S[et] = ebc * (S[et] + U[et]);
                uint2 sv; sv.x = pk2(S[et][0], S[et][1]); sv.y = pk2(S[et][2], S[et][3]);
                *(uint2*)(smem + OFF_ST + (16 * et + fr) * QS + (16 * w + 4 * g) * 2) = sv; }
        };
        SC_ISSUE(ra, 0); SC_STAGE(ra, smem, 0); ebc = ra_eb;
        SC_ISSUE(ra, 1);
        __syncthreads();
        for (int c = 0; c < NCHK + 1; c += 2) {
            SC_ISSUE(rb, c + 2);
            step(c, smem);
            SC_STAGE(ra, smem + BUFB, c + 1); ebc = ra_eb;
            __syncthreads();
            SC_ISSUE(ra, c + 3);
            step(c + 1, smem + BUFB);
            SC_STAGE(rb, smem, c + 2); ebc = rb_eb;
            __syncthreads();
        }
#undef SC_ISSUE
#undef SC_STAGE
    }
}

__device__ __forceinline__ void ph_na3(const Params& p, int layer, unsigned char* smem) {
    const bf16_t* proj = (const bf16_t*)(p.ws + WS_PROJ); const bf16_t* VT = (const bf16_t*)(p.ws + WS_VT);
    bf16_t* mix = (bf16_t*)(p.ws + WS_ACTB);
    const int tid = opaque_tid(), lane = tid & 63, wv = tid >> 6, fr = lane & 15, g = lane >> 4;
    float* bt = (float*)smem;
    constexpr int KS_OFF = 2048, VS_OFF = KS_OFF + 608 * 128, NA_LDS_END = VS_OFF + 76 * 1024;
    static_assert(NA_LDS_END <= LDS_BYTES - 16, "na lds");
    for (int it = xcd_vbid() * 8 + wv; it < 64; it += gridDim.x * 8) {
        const int h = it & 15, b = it >> 4, qrow = b * LL + fr;
        const bf16_t* qp = proj + (size_t)qrow * PPAD + NQ + h * 64 + 16 * g;
        const bf16x8_t q0 = *(const bf16x8_t*)(qp), q1 = *(const bf16x8_t*)(qp + 8);
        const int kkrow = 8 * (fr >> 2) + (fr & 3);
        f32x4_t sc2[2];
#pragma unroll
        for (int pz = 0; pz < 2; ++pz) { const bf16_t* kp = proj + (size_t)(b * LL + kkrow + 4 * pz) * PPAD + NK + h * 64 + 16 * g;
            f32x4_t acc = (f32x4_t){0.f, 0.f, 0.f, 0.f};
            acc = __builtin_amdgcn_mfma_f32_16x16x32_bf16(*(const bf16x8_t*)(kp), q0, acc, 0, 0, 0);
            acc = __builtin_amdgcn_mfma_f32_16x16x32_bf16(*(const bf16x8_t*)(kp + 8), q1, acc, 0, 0, 0);
            sc2[pz] = acc; }
        float mx = -1e30f;
#pragma unroll
        for (int pz = 0; pz < 2; ++pz)
#pragma unroll
            for (int j = 0; j < 4; ++j) { const float sv = (g < 2) ? sc2[pz][j] * 0.125f : -1e30f; sc2[pz][j] = sv; mx = fmaxf(mx, sv); }
        mx = fmaxf(mx, __shfl_xor(mx, 16)); mx = fmaxf(mx, __shfl_xor(mx, 32));
        float lsum = 0.f;
#pragma unroll
        for (int pz = 0; pz < 2; ++pz)
#pragma unroll
            for (int j = 0; j < 4; ++j) { const float pe = __expf(sc2[pz][j] - mx); sc2[pz][j] = pe; lsum += pe; }
        lsum += __shfl_xor(lsum, 16); lsum += __shfl_xor(lsum, 32);
        union { bf16x8_t v; unsigned u[4]; } pb;
        pb.u[0] = pk2(sc2[0][0], sc2[0][1]); pb.u[1] = pk2(sc2[0][2], sc2[0][3]); pb.u[2] = pk2(sc2[1][0], sc2[1][1]); pb.u[3] = pk2(sc2[1][2], sc2[1][3]);
        const bf16_t* vbase = VT + ((size_t)(b * 16 + h) * (LPAD / 8) + g) * 512 + fr * 8;
        const float inv = 1.f / lsum;
        bf16_t* op = mix + (size_t)qrow * DM + 1024 + h * 64 + 4 * g;
#pragma unroll
        for (int mt = 0; mt < 4; ++mt) { f32x4_t o = (f32x4_t){0.f, 0.f, 0.f, 0.f};
            o = __builtin_amdgcn_mfma_f32_16x16x32_bf16(*(const bf16x8_t*)(vbase + 128 * mt), pb.v, o, 0, 0, 0);
            uint2 wv2; wv2.x = pk2(o[0] * inv, o[1] * inv); wv2.y = pk2(o[2] * inv, o[3] * inv); *(uint2*)(op + 16 * mt) = wv2; }
    }
#define NA_F(l_) ((((l_) >> 1) & 1) | ((((l_) >> 3) & 3) << 1))
    for (int rnd = xcd_vbid(); rnd < 1024; rnd += gridDim.x) {
        const bool isgrid = true;
        const int b = rnd >> 8, h = (rnd >> 4) & 15, r0 = 2 * (rnd & 15), r = r0 + (wv >> 2), n = wv & 3;
        const int rsA = min(max(r0 - 4, 0), 24);
        __syncthreads();
        if (tid < 465) bt[tid] = p.relb[((size_t)layer * 16 + h) * 465 + tid];
        {
            typedef unsigned u32x4_t __attribute__((ext_vector_type(4)));
            u32x4_t kst[10], vst[10];
#pragma unroll
            for (int i = 0; i < 10; ++i) { const int idx = min(tid + 512 * i, 608 * 8 - 1), lrow = idx >> 3, ch = idx & 7;
                const int tok = lrow < 576 ? NMETA + min(rsA + (lrow >> 6), 31) * 64 + (lrow & 63) : lrow - 576;
                kst[i] = *(const u32x4_t*)(proj + (size_t)(b * LL + tok) * PPAD + NK + h * 64 + ch * 8); }
#pragma unroll
            for (int i = 0; i < 10; ++i) { const int idx = min(tid + 512 * i, 76 * 64 - 1), gi = idx >> 6, dh = idx & 63;
                const int tg = gi < 72 ? 2 + min(rsA + (gi >> 3), 31) * 8 + (gi & 7) : gi - 72;
                vst[i] = *(const u32x4_t*)(VT + (((size_t)(b * 16 + h) * (LPAD / 8) + tg) * 64 + dh) * 8); }
            __builtin_amdgcn_sched_barrier(0);
#pragma unroll
            for (int i = 0; i < 10; ++i) { const int idx = tid + 512 * i, lrow = idx >> 3, ch = idx & 7;
                if (idx < 608 * 8) *(u32x4_t*)(smem + KS_OFF + lrow * 128 + ((ch ^ NA_F(lrow)) * 16)) = kst[i]; }
#pragma unroll
            for (int i = 0; i < 10; ++i) { const int idx = tid + 512 * i, gi = idx >> 6, dh = idx & 63;
                if (idx < 76 * 64) *(u32x4_t*)(smem + VS_OFF + gi * 1024 + dh * 16) = vst[i]; }
        }
        __syncthreads();
        const int qrow = b * LL + NMETA + r * 64 + 16 * n + fr;
        const int rs = min(max(r - 4, 0), 24), cb = min(max(16 * n - 8, 0), 32);
        const bf16_t* qp = proj + (size_t)qrow * PPAD + NQ + h * 64 + 16 * g;
        const bf16x8_t q0 = *(const bf16x8_t*)(qp), q1 = *(const bf16x8_t*)(qp + 8);
        const int kkrow = 8 * (fr >> 2) + (fr & 3);
        f32x4_t sc[18];
#pragma unroll
        for (int kt = 0; kt < 18; ++kt) { const int kb = kt >> 1;
            const int lrow = (kb < 8 ? (rs - rsA + kb) * 64 + cb : 576) + kkrow + 4 * (kt & 1);
            const unsigned char* kp = smem + KS_OFF + lrow * 128; const int fl = NA_F(lrow);
            const bf16x8_t k0 = *(const bf16x8_t*)(kp + (((2 * g) ^ fl) * 16)), k1 = *(const bf16x8_t*)(kp + (((2 * g + 1) ^ fl) * 16));
            f32x4_t acc = (f32x4_t){0.f, 0.f, 0.f, 0.f};
            acc = __builtin_amdgcn_mfma_f32_16x16x32_bf16(k0, q0, acc, 0, 0, 0);
            acc = __builtin_amdgcn_mfma_f32_16x16x32_bf16(k1, q1, acc, 0, 0, 0);
            sc[kt] = acc; }
        const int qc = 16 * n + fr, cs = min(max(qc - 8, 0), 48);
        const float* bth = bt;
        float mx = -1e30f;
#pragma unroll
        for (int kt = 0; kt < 16; ++kt) { const int dr = rs + (kt >> 1) - r + 7;
#pragma unroll
            for (int j = 0; j < 4; ++j) { const int kc = cb + 8 * g + j + 4 * (kt & 1);
                const bool valid = isgrid && kc >= cs && kc < cs + 16;
                const int dc = min(max(kc - qc, -15), 15) + 15;
                const float sv = valid ? sc[kt][j] * 0.125f + bth[dr * 31 + dc] : -1e30f;
                sc[kt][j] = sv; mx = fmaxf(mx, sv); } }
#pragma unroll
        for (int kt = 16; kt < 18; ++kt)
#pragma unroll
            for (int j = 0; j < 4; ++j) { const float sv = (g < 2) ? sc[kt][j] * 0.125f : -1e30f;
                sc[kt][j] = sv; mx = fmaxf(mx, sv); }
        mx = fmaxf(mx, __shfl_xor(mx, 16)); mx = fmaxf(mx, __shfl_xor(mx, 32));
        float lsum = 0.f;
#pragma unroll
        for (int kt = 0; kt < 18; ++kt)
#pragma unroll
            for (int j = 0; j < 4; ++j) { const float pe = __expf(sc[kt][j] - mx); sc[kt][j] = pe; lsum += pe; }
        lsum += __shfl_xor(lsum, 16); lsum += __shfl_xor(lsum, 32);
        f32x4_t o[4];
#pragma unroll
        for (int mt = 0; mt < 4; ++mt) o[mt] = (f32x4_t){0.f, 0.f, 0.f, 0.f};
#pragma unroll
        for (int kb = 0; kb < 9; ++kb) {
            union { bf16x8_t v; unsigned u[4]; } pb;
            pb.u[0] = pk2(sc[2 * kb][0], sc[2 * kb][1]); pb.u[1] = pk2(sc[2 * kb][2], sc[2 * kb][3]);
            pb.u[2] = pk2(sc[2 * kb + 1][0], sc[2 * kb + 1][1]); pb.u[3] = pk2(sc[2 * kb + 1][2], sc[2 * kb + 1][3]);
            const unsigned char* vp = smem + VS_OFF + ((kb < 8 ? (rs - rsA + kb) * 8 + (cb >> 3) : 72) + g) * 1024 + fr * 16;
#pragma unroll
            for (int mt = 0; mt < 4; ++mt) o[mt] = __builtin_amdgcn_mfma_f32_16x16x32_bf16(*(const bf16x8_t*)(vp + 256 * mt), pb.v, o[mt], 0, 0, 0);
        }
        const float inv = 1.f / lsum;
        bf16_t* op = mix + (size_t)qrow * DM + 1024 + h * 64 + 4 * g;
#pragma unroll
        for (int mt = 0; mt < 4; ++mt) { uint2 wv2; wv2.x = pk2(o[mt][0] * inv, o[mt][1] * inv); wv2.y = pk2(o[mt][2] * inv, o[mt][3] * inv); *(uint2*)(op + 16 * mt) = wv2; }
    }
#undef NA_F
}

__device__ __forceinline__ void ph_ln(const Params& p, const float* w, const float* bvec, bool final_out, int nseg, unsigned char* smem) {
    bf16_t* hres = (bf16_t*)(p.ws + WS_HRES); const bf16_t* y = (const bf16_t*)(p.ws + WS_Y); const float* part = (const float*)(p.ws + WS_PART);
    const int tid_ = opaque_tid(), lane = tid_ & 63, wv = tid_ >> 6;
#define LN_FINISH(row_) { \
        float s = 0.f; \
        _Pragma("unroll") for (int j = 0; j < 4; ++j) { \
            v[2 * j] = DN_ALPHA * (f32x4_t){bf_lo(hr[j].x), bf_hi(hr[j].x), bf_lo(hr[j].y), bf_hi(hr[j].y)} + v[2 * j]; \
            v[2 * j + 1] = DN_ALPHA * (f32x4_t){bf_lo(hr[j].z), bf_hi(hr[j].z), bf_lo(hr[j].w), bf_hi(hr[j].w)} + v[2 * j + 1]; \
            s += (v[2 * j][0] + v[2 * j][1]) + (v[2 * j][2] + v[2 * j][3]) + (v[2 * j + 1][0] + v[2 * j + 1][1]) + (v[2 * j + 1][2] + v[2 * j + 1][3]); } \
        const float mean = wave_sum(s) * (1.f / DM); float s2 = 0.f; \
        _Pragma("unroll") for (int j = 0; j < 8; ++j) { v[j] = v[j] - mean; s2 += (v[j][0] * v[j][0] + v[j][1] * v[j][1]) + (v[j][2] * v[j][2] + v[j][3] * v[j][3]); } \
        const float rstd = 1.0f / sqrtf(wave_sum(s2) * (1.f / DM) + LN_EPS); \
        const int b_ = (row_) / LL, l_ = (row_) % LL; \
        if (!(final_out && l_ < NMETA)) { float* orow = p.out + ((size_t)b_ * TT + (l_ - NMETA)) * DM; \
            _Pragma("unroll") for (int j = 0; j < 4; ++j) { const int cc = j * 512 + lane * 8; \
                const f32x4_t o0 = v[2 * j] * rstd * lw[2 * j] + lb[2 * j]; \
                const f32x4_t o1 = v[2 * j + 1] * rstd * lw[2 * j + 1] + lb[2 * j + 1]; \
                if (final_out) { *(f32x4_t*)(orow + cc) = o0; *(f32x4_t*)(orow + cc + 4) = o1; } \
                else { uint4 pk; pk.x = pk2(o0[0], o0[1]); pk.y = pk2(o0[2], o0[3]); pk.z = pk2(o1[0], o1[1]); pk.w = pk2(o1[2], o1[3]); \
                    *(uint4*)(hres + (size_t)(row_) * DM + cc) = pk; } } } }
    {
        f32x4_t lw[8], lb[8];
#pragma unroll
        for (int j = 0; j < 4; ++j) { const int cc = j * 512 + lane * 8;
            lw[2 * j] = *(const f32x4_t*)(w + cc); lw[2 * j + 1] = *(const f32x4_t*)(w + cc + 4); lb[2 * j] = *(const f32x4_t*)(bvec + cc); lb[2 * j + 1] = *(const f32x4_t*)(bvec + cc + 4); }
        const int stride = gridDim.x * 8; int row = opaque_bid() * 8 + wv;
        uint4 hr[4], yr[4], hn[4], yn[4];
        if (row < 8192) {
#pragma unroll
            for (int j = 0; j < 4; ++j) { hr[j] = *(const uint4*)(hres + (size_t)row * DM + j * 512 + lane * 8); yr[j] = *(const uint4*)(y + (size_t)row * DM + j * 512 + lane * 8); }
        }
        for (; row < 8192; row += stride) {
            const int nrow = min(row + stride, 8191);
#pragma unroll
            for (int j = 0; j < 4; ++j) { hn[j] = *(const uint4*)(hres + (size_t)nrow * DM + j * 512 + lane * 8); yn[j] = *(const uint4*)(y + (size_t)nrow * DM + j * 512 + lane * 8); }
            __builtin_amdgcn_sched_barrier(0);
            f32x4_t v[8];
#pragma unroll
            for (int j = 0; j < 4; ++j) { v[2 * j] = (f32x4_t){bf_lo(yr[j].x), bf_hi(yr[j].x), bf_lo(yr[j].y), bf_hi(yr[j].y)}; v[2 * j + 1] = (f32x4_t){bf_lo(yr[j].z), bf_hi(yr[j].z), bf_lo(yr[j].w), bf_hi(yr[j].w)}; }
            LN_FINISH(row)
#pragma unroll
            for (int j = 0; j < 4; ++j) { hr[j] = hn[j]; yr[j] = yn[j]; }
        }
    }
    {
        float* red = (float*)smem;
        for (int rr = opaque_bid(); rr < 64; rr += gridDim.x) {
            const int row = 8192 + rr, col = wv * 256 + lane * 4;
            const uint2 hraw = *(const uint2*)(hres + (size_t)row * DM + col);
            f32x4_t yv = (f32x4_t){0.f, 0.f, 0.f, 0.f};
            for (int q = 0; q < nseg; q += 16) {
                f32x4_t pv[16];
#pragma unroll
                for (int qq = 0; qq < 16; ++qq) pv[qq] = *(const f32x4_t*)(part + ((size_t)(q + qq) * 64 + rr) * DM + col);
                __builtin_amdgcn_sched_barrier(0);
#pragma unroll
                for (int qq = 0; qq < 16; ++qq) yv += pv[qq]; }
            f32x4_t x = DN_ALPHA * (f32x4_t){bf_lo(hraw.x), bf_hi(hraw.x), bf_lo(hraw.y), bf_hi(hraw.y)} + yv;
            const float s = wave_sum((x[0] + x[1]) + (x[2] + x[3]));
            __syncthreads();
            if (lane == 0) red[wv] = s;
            __syncthreads();
            float tot = 0.f;
#pragma unroll
            for (int i = 0; i < 8; ++i) tot += red[i];
            const float mean = tot * (1.f / DM);
            x = x - mean;
            const float s2 = wave_sum((x[0] * x[0] + x[1] * x[1]) + (x[2] * x[2] + x[3] * x[3]));
            if (lane == 0) red[8 + wv] = s2;
            __syncthreads();
            float tot2 = 0.f;
#pragma unroll
            for (int i = 0; i < 8; ++i) tot2 += red[8 + i];
            const float rstd = 1.0f / sqrtf(tot2 * (1.f / DM) + LN_EPS);
            const f32x4_t o = x * rstd * *(const f32x4_t*)(w + col) + *(const f32x4_t*)(bvec + col);
            const int b_ = row / LL, l_ = row % LL;
            if (final_out) *(f32x4_t*)(p.out + ((size_t)b_ * TT + (l_ - NMETA)) * DM + col) = o;
            else { uint2 pk; pk.x = pk2(o[0], o[1]); pk.y = pk2(o[2], o[3]); *(uint2*)(hres + (size_t)row * DM + col) = pk; }
        }
    }
#undef LN_FINISH
}

struct SplitOrder {
    pg8::StaticOrder so; int nfull, nseg, segk, nN, nMfull, G, c;
    __device__ void init(int nMfull_, int N, int K, int nsegk, int G_, int c_) { nMfull = nMfull_; nN = N / 256; G = G_; c = c_; so.init(nMfull_ * 256, N, G_, c_); so.ntile = K / 64; nfull = nMfull_ * nN;
        segk = nsegk > 0 ? (K / 64) / nsegk : 0; nseg = nsegk * nN; }
    __device__ bool next(int i, pg8::Unit& u) const {
        const int L = i * G + c;
        if (L < nfull) return so.next(i, u);
        const int j = L - nfull; if (j >= nseg) return false;
        u.pm = nMfull; u.pn = j % nN; u.k0 = (j / nN) * segk; u.nt = segk; u.kind = 1; return true;
    }
    __device__ __forceinline__ void a_ready(const pg8::Unit&) const {}
    __device__ __forceinline__ void done(const pg8::Unit&) const {}
};
template <class Epi> __device__ __forceinline__ void ph_gemm(unsigned char* smem, const bf16_t* A, const bf16_t* Bt, int M, int N, int K, int nsegk, const Epi& E, int nMfull = -1) {
    asm volatile("" : "+s"(M), "+s"(N), "+s"(K), "+s"(nsegk));
    pg8::Gemm g; g.A = A; g.Bt = Bt; g.M = M; g.N = N; g.K = K;
    if (nMfull < 0) nMfull = nsegk > 0 ? M / 256 - 1 : M / 256;
    SplitOrder S; S.init(nMfull, N, K, nsegk, (int)gridDim.x, opaque_bid());
    pg8::gemm_phase<Epi, SplitOrder, true, true>((PG8_LAS unsigned char*)smem, g, S, E);
}

#ifndef MK_REP_MASK
#define MK_REP_MASK 0
#endif
template <int ACT> __device__ __forceinline__ void skinny_task(const bf16_t* A, const bf16_t* Bt, int K, int row0, int col0, bf16_t* O, int ldc, int tid, unsigned char* smem) {
    const int lane = tid & 63, w = tid >> 6, fr = lane & 15, g = lane >> 4;
    asm volatile("" : "+s"(K) :: "memory");
    const int kw = K >> 3;
    const bf16_t* ap = A + (size_t)(row0 + fr) * K + w * kw + 8 * g;
    const bf16_t* bp = Bt + (size_t)(col0 + fr) * K + w * kw + 8 * g;
    f32x4_t acc[4][2];
#pragma unroll
    for (int rt = 0; rt < 4; ++rt) { acc[rt][0] = (f32x4_t){0.f, 0.f, 0.f, 0.f}; acc[rt][1] = acc[rt][0]; }
    for (int k0 = 0; k0 < kw; k0 += 128) {
        bf16x8_t a[4][4], bb[2][4];
#pragma unroll
        for (int i = 0; i < 4; ++i) {
#pragma unroll
            for (int rt = 0; rt < 4; ++rt) a[rt][i] = *(const bf16x8_t*)(ap + (size_t)(16 * rt) * K + k0 + 32 * i);
#pragma unroll
            for (int ct = 0; ct < 2; ++ct) bb[ct][i] = *(const bf16x8_t*)(bp + (size_t)(16 * ct) * K + k0 + 32 * i); }
        __builtin_amdgcn_sched_barrier(0);
#pragma unroll
        for (int i = 0; i < 4; ++i)
#pragma unroll
            for (int rt = 0; rt < 4; ++rt)
#pragma unroll
                for (int ct = 0; ct < 2; ++ct) acc[rt][ct] = __builtin_amdgcn_mfma_f32_16x16x32_bf16(bb[ct][i], a[rt][i], acc[rt][ct], 0, 0, 0);
    }
    f32x4_t* red = (f32x4_t*)smem;
#pragma unroll
    for (int rt = 0; rt < 4; ++rt)
#pragma unroll
        for (int ct = 0; ct < 2; ++ct) red[(w * 8 + rt * 2 + ct) * 64 + lane] = acc[rt][ct];
    __syncthreads();
    f32x4_t r = red[(0 * 8 + w) * 64 + lane];
#pragma unroll
    for (int q = 1; q < 8; ++q) r += red[(q * 8 + w) * 64 + lane];
    if (ACT == 1) {
#pragma unroll
        for (int j = 0; j < 4; ++j) { const float x = fmaxf(r[j], 0.f); r[j] = x * x; } }
    const int rt = w >> 1, ct = w & 1;
    uint2 o; o.x = pk2(r[0], r[1]); o.y = pk2(r[2], r[3]);
    *(uint2*)(O + (size_t)(row0 + 16 * rt + fr) * ldc + col0 + 16 * ct + 4 * g) = o;
    __syncthreads();
}

#ifndef MK_REP_MASK
#define MK_REP_MASK 0
#endif
constexpr int PH_PER_LAYER = 9, NPH = 1 + NLAYER * PH_PER_LAYER;

__device__ __forceinline__ void run_phase(const Params& p, int ph, unsigned char* smem) {
    if (ph == 0) { ph_prologue(p, smem); return; }
    const int layer = (ph - 1) / PH_PER_LAYER, s = (ph - 1) % PH_PER_LAYER;
    unsigned char* ws = p.ws;
    switch (s) {
    case 0: { pg8::EpiBf16<0> E; E.O = (bf16_t*)(ws + WS_PROJ); E.ldc = PPAD;
              const bf16_t* A = (const bf16_t*)(ws + WS_HRES); const bf16_t* Bt = (const bf16_t*)(ws + WS_WT_IN + layer * SZ_WT_IN);
              ph_gemm(smem, A, Bt, MPAD, 6144, DM, 0, E, 32);
              const int tid = opaque_tid();
              for (int t = opaque_bid(); t < 193 + 128; t += gridDim.x) {
                  if (t < 193) skinny_task<0>(A, Bt, DM, 8192, 32 * t, (bf16_t*)(ws + WS_PROJ), PPAD, tid, smem);
                  else skinny_task<0>(A, Bt, DM, 64 * (t - 193), 6144, (bf16_t*)(ws + WS_PROJ), PPAD, tid, smem); } } break;
    case 1: ph_gla_prep(p, layer, smem);
#if MK_REP_MASK & (1 << 22)
            ph_gla_prep(p, layer, smem);
#endif
            ph_vt(p, smem);
#if MK_REP_MASK & (1 << 23)
            ph_vt(p, smem);
#endif
            break;
    case 2: ph_gla_scan2(p, layer, smem); break;
    case 3: ph_na3(p, layer, smem);
#if MK_REP_MASK & (1 << 20)
            ph_na3(p, layer, smem);
#endif
            ph_gla_combine(p, layer);
#if MK_REP_MASK & (1 << 21)
            ph_gla_combine(p, layer);
#endif
            break;
    case 4: { pg8::EpiY E; E.Y = (bf16_t*)(ws + WS_Y); E.ldc = DM; E.part = (float*)(ws + WS_PART);
              ph_gemm(smem, (const bf16_t*)(ws + WS_ACTB), (const bf16_t*)(ws + WS_WT_OUT + layer * SZ_WT_OUT), MPAD, DM, DM, NSEG_OUT, E); } break;
    case 5: ph_ln(p, p.ln1w + layer * DM, p.ln1b + layer * DM, false, NSEG_OUT, smem); break;
    case 6: { pg8::EpiBf16<1> E; E.O = (bf16_t*)(ws + WS_HID); E.ldc = DFF;
              const bf16_t* A = (const bf16_t*)(ws + WS_HRES); const bf16_t* Bt = (const bf16_t*)(ws + WS_WT_FF1 + layer * SZ_WT_FF);
              ph_gemm(smem, A, Bt, MPAD, DFF, DM, 0, E, 32);
              const int tid = opaque_tid();
              for (int t = opaque_bid(); t < 256; t += gridDim.x) skinny_task<1>(A, Bt, DM, 8192, 32 * t, (bf16_t*)(ws + WS_HID), DFF, tid, smem); } break;
    case 7: { pg8::EpiY E; E.Y = (bf16_t*)(ws + WS_Y); E.ldc = DM; E.part = (float*)(ws + WS_PART);
              ph_gemm(smem, (const bf16_t*)(ws + WS_HID), (const bf16_t*)(ws + WS_WT_FF2 + layer * SZ_WT_FF), MPAD, DM, DFF, NSEG_FF2, E); } break;
    default: ph_ln(p, p.ln2w + layer * DM, p.ln2b + layer * DM, layer == NLAYER - 1, NSEG_FF2, smem); break;
    }
}

__global__ __launch_bounds__(512, 2) void mega_fwd(Params p) {
    extern __shared__ __attribute__((aligned(16))) unsigned char smem[];
    volatile LAS unsigned* xst = (volatile LAS unsigned*)(LAS unsigned char*)(smem + LDS_BYTES - 16);
    XcdBarrier xb;
    if (p.coop) {
        if (threadIdx.x == 0) { xst[0] = 0u; xst[1] = 0u; }
        __syncthreads();
        xb = xcd_barrier_post((unsigned*)(p.ws + WS_BAR), xst);
    }
#if MK_REP_MASK & (1 << 17)
    if (p.coop) for (int i = 0; i < 20; ++i) xcd_barrier(xb);
#endif
    for (int ph = p.ph_lo; ph < p.ph_hi; ++ph) {
        if (ph > p.ph_lo && p.coop) {
            if (p.pad != 0) cg::this_grid().sync();
            xcd_barrier(xb);
        }
        run_phase(p, ph, smem);
#if MK_REP_MASK
        if (ph > 0 ? ((MK_REP_MASK >> ((ph - 1) % PH_PER_LAYER)) & 1) : ((MK_REP_MASK >> 16) & 1)) { if (p.coop) xcd_barrier(xb); run_phase(p, ph, smem); }
#endif
    }
}

#ifndef MK_ONE_LAUNCH
#define MK_ONE_LAUNCH 0
#endif

extern "C" void kernel_launch(void* const* d_in, const int* in_sizes, int n_in, void* d_out, int out_size, void* d_ws, size_t ws_size, hipStream_t stream) {
    static int grid = 0;
    if (grid == 0) {
        if (n_in != 14 || in_sizes[0] != NB * TT * DM || out_size != NB * TT * DM || ws_size < WS_TOTAL) {
            fprintf(stderr, "kernel_launch: unexpected shapes or workspace (%zu < %zu); nothing launched\n", ws_size, (size_t)WS_TOTAL); grid = -1; return; }
        int dev = 0, cus = 0, per_cu = 0;
        hipGetDevice(&dev); hipDeviceGetAttribute(&cus, hipDeviceAttributeMultiprocessorCount, dev);
        if (hipFuncSetAttribute((const void*)mega_fwd, hipFuncAttributeMaxDynamicSharedMemorySize, LDS_BYTES) != hipSuccess) { fprintf(stderr, "kernel_launch: hipFuncSetAttribute failed\n"); grid = -1; return; }
        if (hipOccupancyMaxActiveBlocksPerMultiprocessor(&per_cu, (const void*)mega_fwd, 512, LDS_BYTES) != hipSuccess || per_cu < 1) { fprintf(stderr, "kernel_launch: occupancy query failed (%d)\n", per_cu); (void)hipGetLastError(); per_cu = 1; }
        grid = cus * per_cu;
    }
    if (grid < 0) return;
#if MK_ONE_LAUNCH
    if (hipMemsetAsync((char*)d_ws + WS_BAR, 0, (size_t)XCD_BAR_WORDS * 4, stream) != hipSuccess) { fprintf(stderr, "kernel_launch: memset of the barrier words failed\n"); return; }
#endif
    Params p{};
    p.x = (const float*)d_in[0]; p.meta = (const float*)d_in[1]; p.w_in = (const float*)d_in[2]; p.w_up = (const float*)d_in[3]; p.b_up = (const float*)d_in[4];
    p.gnorm = (const float*)d_in[5]; p.relb = (const float*)d_in[6]; p.w_out = (const float*)d_in[7]; p.ln1w = (const float*)d_in[8]; p.ln1b = (const float*)d_in[9];
    p.w_ff1 = (const float*)d_in[10]; p.w_ff2 = (const float*)d_in[11]; p.ln2w = (const float*)d_in[12]; p.ln2b = (const float*)d_in[13];
    p.out = (float*)d_out; p.ws = (unsigned char*)d_ws;
#if MK_ONE_LAUNCH
    p.ph_lo = 0; p.ph_hi = NPH; p.coop = 1;
    void* args[] = {&p};
    hipError_t e = hipLaunchCooperativeKernel((const void*)mega_fwd, dim3(grid), dim3(512), args, LDS_BYTES, stream);
    if (e != hipSuccess) fprintf(stderr, "cooperative launch failed: %s (grid %d)\n", hipGetErrorString(e), grid);
#else
    for (int ph = 0; ph < NPH; ++ph) {
        p.ph_lo = ph; p.ph_hi = ph + 1; p.coop = 0;
        hipLaunchKernelGGL(mega_fwd, dim3(grid), dim3(512), LDS_BYTES, stream, p);
    }
#endif
}
```
